# Optimizing an MI355X kernel written in HIP

```python
import math
import jax, jax.numpy as jnp
from jax import lax
import numpy as np

D_MODEL = 2048
BATCH = 4
SEQ = 4096
DEPTH = 1

HEAD_DIM = 64
N_HEADS = D_MODEL // 256
ATTN_WIDTH = N_HEADS * 2 * HEAD_DIM
POOL_WINDOWS = (2, 4, 8, 16)
N_POOL_GROUPS = len(POOL_WINDOWS)
POOL_WIDTH = D_MODEL // 2
POOL_GROUP_DIM = POOL_WIDTH // N_POOL_GROUPS
N_BRANCH = 2
IN_COLS = 3 * ATTN_WIDTH + POOL_WIDTH + N_BRANCH * D_MODEL
D_FF = (11 * D_MODEL // 4) // 128 * 128
CONV_WIDTH = 3
Q_BLOCK = 128
NORM_EPS = 1e-6
SUBLN_EPS = 1e-5

kernel_name = 'hybrid_diffattn_pool_convffn_block'


def rms_norm(x, g, eps=NORM_EPS):
    xf = x.astype(jnp.float32)
    y = xf * lax.rsqrt(jnp.mean(xf * xf, axis=-1, keepdims=True) + eps)
    return (y * g.astype(jnp.float32)).astype(x.dtype)


def alibi_slopes():
    return jnp.asarray(np.array([2.0 ** (-8.0 * (h + 1) / N_HEADS) for h in range(N_HEADS)], dtype=np.float32))


def diff_attention(q, k, v, lam, slopes):
    B, S = q.shape[0], q.shape[1]
    nb = S // Q_BLOCK
    q_blocks = q.reshape(B, nb, Q_BLOCK, N_HEADS, 2, HEAD_DIM).transpose(1, 0, 2, 3, 4, 5)
    starts = jnp.arange(nb, dtype=jnp.int32) * Q_BLOCK
    key_pos = jnp.arange(S, dtype=jnp.int32)
    scale = HEAD_DIM ** -0.5

    def one_block(args):
        qb, start = args
        s = jnp.einsum('bqhcd,bkhcd->bhcqk', qb, k).astype(jnp.float32) * scale
        q_pos = start + jnp.arange(Q_BLOCK, dtype=jnp.int32)
        dist = jnp.abs(q_pos[:, None] - key_pos[None, :]).astype(jnp.float32)
        s = s - slopes[None, :, None, None, None] * dist[None, None, None]
        p = jax.nn.softmax(s, axis=-1)
        a = p[:, :, 0] - lam * p[:, :, 1]
        return jnp.einsum('bhqk,bkhe->bqhe', a.astype(v.dtype), v)

    out = lax.map(one_block, (q_blocks, starts))
    return out.transpose(1, 0, 2, 3, 4).reshape(B, S, N_HEADS, 2 * HEAD_DIM)


def pool_mixer(p, pool_w, pool_scale):
    B, S, _ = p.shape
    pg = p.reshape(B, S, N_POOL_GROUPS, POOL_GROUP_DIM)
    pf = pg.astype(jnp.float32)
    csum = jnp.pad(jnp.cumsum(pf, axis=1), ((0, 0), (1, 0), (0, 0), (0, 0)))
    t = jnp.arange(S, dtype=jnp.int32)
    halves = jnp.asarray(np.array([w // 2 for w in POOL_WINDOWS], dtype=np.int32))
    lo = jnp.clip(t[None, :] - halves[:, None], 0, S)
    hi = jnp.clip(t[None, :] + halves[:, None], 0, S)
    cnt = (hi - lo).astype(jnp.float32)
    c_g = csum.transpose(2, 0, 1, 3)
    take = jax.vmap(lambda cg, idx: cg[:, idx])
    win_sum = take(c_g, hi) - take(c_g, lo)
    mean = win_sum / cnt[:, None, :, None]
    mixed = (mean.transpose(1, 2, 0, 3) - pf).astype(p.dtype)
    y = jnp.einsum('bsgc,gcd->bsgd', mixed, pool_w)
    y = y * pool_scale.reshape(N_POOL_GROUPS, POOL_GROUP_DIM)
    return y.reshape(B, S, POOL_WIDTH)


def depthwise_conv_centred(u, w, b):
    up = jnp.pad(u, ((0, 0), (1, 1), (0, 0)))
    return up[:, :-2] * w[0] + up[:, 1:-1] * w[1] + up[:, 2:] * w[2] + b


def setup_inputs(seed: int = 0) -> dict:
    key = jax.random.key(seed)
    ks = jax.random.split(key, 24)
    f = jnp.float32
    L = DEPTH

    def nrm(k, shape, s):
        return jax.random.normal(k, shape, f) * s

    return {
        'x': nrm(ks[0], (BATCH, SEQ, D_MODEL), 1.0),
        'g_pre_mix': 1.0 + nrm(ks[1], (L, D_MODEL), 0.02),
        'w_in': nrm(ks[2], (L, D_MODEL, IN_COLS), D_MODEL ** -0.5),
        'b_gate': nrm(ks[3], (L, N_BRANCH * D_MODEL), 0.02),
        'lambda_q1': nrm(ks[4], (L, HEAD_DIM), 0.1),
        'lambda_k1': nrm(ks[5], (L, HEAD_DIM), 0.1),
        'lambda_q2': nrm(ks[6], (L, HEAD_DIM), 0.1),
        'lambda_k2': nrm(ks[7], (L, HEAD_DIM), 0.1),
        'subln_gain': 1.0 + nrm(ks[8], (L, 2 * HEAD_DIM), 0.02),
        'w_attn_branch': nrm(ks[9], (L, ATTN_WIDTH, D_MODEL), ATTN_WIDTH ** -0.5),
        'pool_w': nrm(ks[10], (L, N_POOL_GROUPS, POOL_GROUP_DIM, POOL_GROUP_DIM), POOL_GROUP_DIM ** -0.5),
        'pool_scale': 1.0 + nrm(ks[11], (L, POOL_WIDTH), 0.02),
        'w_pool_branch': nrm(ks[12], (L, POOL_WIDTH, D_MODEL), POOL_WIDTH ** -0.5),
        'w_out': nrm(ks[13], (L, D_MODEL, D_MODEL), D_MODEL ** -0.5),
        'g_post_mix': 1.0 + nrm(ks[14], (L, D_MODEL), 0.02),
        'g_pre_ffn': 1.0 + nrm(ks[15], (L, D_MODEL), 0.02),
        'w_up': nrm(ks[16], (L, D_MODEL, 2 * D_FF), D_MODEL ** -0.5),
        'conv_w': nrm(ks[17], (L, CONV_WIDTH, 2 * D_FF), CONV_WIDTH ** -0.5),
        'conv_b': nrm(ks[18], (L, 2 * D_FF), 0.02),
        'w_down': nrm(ks[19], (L, D_FF, D_MODEL), D_FF ** -0.5),
        'g_post_ffn': 1.0 + nrm(ks[20], (L, D_MODEL), 0.02),
    }


def reference(x, g_pre_mix, w_in, b_gate, lambda_q1, lambda_k1, lambda_q2, lambda_k2, subln_gain,
              w_attn_branch, pool_w, pool_scale, w_pool_branch, w_out, g_post_mix,
              g_pre_ffn, w_up, conv_w, conv_b, w_down, g_post_ffn):
    B, S, D = x.shape
    slopes = alibi_slopes()
    splits = [ATTN_WIDTH, 2 * ATTN_WIDTH, 3 * ATTN_WIDTH, 3 * ATTN_WIDTH + POOL_WIDTH]
    for l in range(DEPTH):
        lambda_init = 0.8 - 0.6 * math.exp(-0.3 * l)
        h = rms_norm(x, g_pre_mix[l])
        z = h @ w_in[l]
        q, k, v, pz, gz = jnp.split(z, splits, axis=-1)
        q = q.reshape(B, S, N_HEADS, 2, HEAD_DIM)
        k = k.reshape(B, S, N_HEADS, 2, HEAD_DIM)
        v = v.reshape(B, S, N_HEADS, 2 * HEAD_DIM)
        lam = (jnp.exp(jnp.sum(lambda_q1[l].astype(jnp.float32) * lambda_k1[l].astype(jnp.float32)))
               - jnp.exp(jnp.sum(lambda_q2[l].astype(jnp.float32) * lambda_k2[l].astype(jnp.float32)))
               + lambda_init)
        o = diff_attention(q, k, v, lam, slopes)
        o = rms_norm(o, subln_gain[l], SUBLN_EPS) * (1.0 - lambda_init)
        y_attn = o.reshape(B, S, ATTN_WIDTH) @ w_attn_branch[l]
        y_pool = pool_mixer(pz, pool_w[l], pool_scale[l]) @ w_pool_branch[l]
        gates = jax.nn.sigmoid(gz + b_gate[l]).reshape(B, S, N_BRANCH, D)
        merged = gates[:, :, 0] * y_attn + gates[:, :, 1] * y_pool
        x = x + rms_norm(merged @ w_out[l], g_post_mix[l])
        h2 = rms_norm(x, g_pre_ffn[l])
        u = depthwise_conv_centred(h2 @ w_up[l], conv_w[l], conv_b[l])
        gate, val = jnp.split(u, 2, axis=-1)
        y = (jax.nn.gelu(gate) * val) @ w_down[l]
        x = x + rms_norm(y, g_post_ffn[l])
    return x
```

```cpp
#include <hip/hip_runtime.h>
#include <hip/hip_cooperative_groups.h>
#include <cstdio>
#include <cstdint>
namespace cg = cooperative_groups;

#define LAS __attribute__((address_space(3)))
typedef unsigned short bf16_t;
typedef short bf16x8 __attribute__((ext_vector_type(8)));
typedef float f32x4 __attribute__((ext_vector_type(4)));
typedef float f32x16 __attribute__((ext_vector_type(16)));
typedef unsigned u32x4 __attribute__((ext_vector_type(4)));
typedef unsigned u32x2 __attribute__((ext_vector_type(2)));

constexpr int NB = 4, SEQ = 4096, DM = 2048, M = NB * SEQ, NH = 8;
constexpr int INC = 8192, DFF = 5632, UPC = 2 * DFF;
constexpr float NORM_EPS = 1e-6f, SUBLN_EPS = 1e-5f, LAMBDA_INIT = 0.2f;
constexpr float LOG2E = 1.4426950408889634f;

constexpr size_t MiB = 1u << 20;
constexpr size_t WS_WDOWN = 0;
constexpr size_t WS_WIN = 22 * MiB;
constexpr size_t WS_WOUT = 54 * MiB;
constexpr size_t WS_WCAT = 62 * MiB;
constexpr size_t WS_WPT = 70 * MiB;
constexpr size_t WS_PWS = 74 * MiB;
constexpr size_t WS_H = 75 * MiB;
constexpr size_t WS_OPM = 75 * MiB;
constexpr size_t WS_QK = 139 * MiB;
constexpr size_t WS_MERGED = 139 * MiB;
constexpr size_t WS_VT = 203 * MiB;
constexpr size_t WS_PZ = 235 * MiB;
constexpr size_t WS_T = 203 * MiB;
constexpr size_t WS_GATES = 267 * MiB;
constexpr size_t WS_MO = 203 * MiB;
constexpr size_t WS_H2 = 385 * MiB;
constexpr size_t WS_WUP = 449 * MiB;
constexpr size_t WS_U = 22 * MiB;
constexpr size_t WS_SIDE = 198 * MiB;
constexpr size_t WS_Y = 374 * MiB;
constexpr size_t WS_CTL = 502 * MiB;
constexpr size_t WS_NEED = 503 * MiB;

typedef float f32x2_t __attribute__((ext_vector_type(2))); typedef __bf16 bf16x2_t __attribute__((ext_vector_type(2)));
__device__ __forceinline__ unsigned cvt_pk_bf16(float lo, float hi) { const f32x2_t v = {lo, hi}; const bf16x2_t b = __builtin_convertvector(v, bf16x2_t); return __builtin_bit_cast(unsigned, b); }
__device__ __forceinline__ float bf_lo(unsigned w) { return __uint_as_float(w << 16); }
__device__ __forceinline__ float bf_hi(unsigned w) { return __uint_as_float(w & 0xffff0000u); }
__device__ __forceinline__ float sigmoidf_(float x) { return __builtin_amdgcn_rcpf(1.0f + __builtin_amdgcn_exp2f(-x * LOG2E)); }
__device__ __forceinline__ float gelu_tanh(float x) { const float z = 0.7978845608028654f * (x + 0.044715f * x * x * x); return x * __builtin_amdgcn_rcpf(1.0f + __builtin_amdgcn_exp2f(-2.0f * LOG2E * z)); }

__device__ __forceinline__ int lane_id_volatile() { int l; asm volatile("v_mbcnt_lo_u32_b32 %0, -1, 0\n\tv_mbcnt_hi_u32_b32 %0, -1, %0" : "=v"(l)); return l; }
#define MY_TID(w0) (((w0) << 6) | lane_id_volatile())
namespace pg8 {
constexpr int BM = 256, BK = 64, HALF = 128, HTB = HALF * BK * 2, STAGE_BYTES = 8 * HTB, NXCD = 8, WGM = 8;
__host__ __device__ __forceinline__ int lds_byte(int r, int c) { const int st = (r >> 4) * 2 + (c >> 5), rr = r & 15, cc = c & 31, ob = rr * 64 + cc * 2; return st * 1024 + (ob ^ (((ob >> 9) & 1) << 5)); }
__host__ __device__ __forceinline__ void stage_rc(int b, int& R, int& C) { const int st = b / 1024, sb = b % 1024, swz = sb ^ (((sb >> 9) & 1) << 5); R = (st >> 1) * 16 + swz / 64; C = (st & 1) * 32 + (swz % 64) / 2; }
__host__ __device__ __forceinline__ int perm32(int rho) { const int n = rho >> 4, i = rho & 15; return 8 * (i >> 2) + 4 * n + (i & 3); }

struct Unit { int pm, pn; };
struct Gemm { const bf16_t* A; const bf16_t* Bt; int lda, ldb, K, ak2, apn; };

struct StaticOrder {
    int nM, nN, nwg, G, c;
    __device__ void init(int M_, int N_, int G_, int c_) { nM = M_ / BM; nN = N_ / BM; nwg = nM * nN; G = G_; c = c_; }
    __device__ bool next(int i, Unit& u) const {
        const long L = (long)i * G + c; if (L >= nwg) return false;
        int wgid = (int)L; { const int q = nwg / NXCD, r = nwg % NXCD, xcd = wgid % NXCD, off = wgid / NXCD; wgid = (xcd < r ? xcd * (q + 1) : r * (q + 1) + (xcd - r) * q) + off; }
        const int nig = WGM * nN, gid = wgid / nig, fm = gid * WGM, gsz = (nM - fm) < WGM ? (nM - fm) : WGM;
        u.pm = fm + ((wgid % nig) % gsz); u.pn = (wgid % nig) / gsz; return true;
    }
};

typedef f32x4 Acc[2][2][4][2];

template <class Epi>
__device__ __forceinline__ void gemm_phase(LAS unsigned char* lds, const Gemm g, const StaticOrder& S, const Epi& E, int wave0) {
    int tid_ = MY_TID(wave0); asm volatile("" : "+v"(tid_));
    const int tid = tid_, wid = __builtin_amdgcn_readfirstlane(tid >> 6), lane = tid & 63, wr = wid >> 2, wc = wid & 3, fr = lane & 15, fq = lane >> 4;
    const int K = g.K, nt = K / BK;
    unsigned voffA[2], voffB[2];
#pragma unroll
    for (int i = 0; i < 2; ++i) { int R, C; stage_rc(tid * 16 + i * 8192, R, C); const int Rb = Epi::PERM ? ((R & ~31) + perm32(R & 31)) : R;
        voffA[i] = (unsigned)(R * g.lda + C) * 2u; voffB[i] = (unsigned)(Rb * g.ldb + C) * 2u; }
    const size_t kstep = (size_t)(BK * 2);
    const size_t ak2 = (size_t)g.ak2;
    const size_t hstepA = (size_t)HALF * g.lda * 2, hstepB = (size_t)HALF * g.ldb * 2;
    const size_t tstepA = 2 * hstepA, tstepB = 2 * hstepB;
    const unsigned ldsw = (unsigned)wid * 1024u;
    const int aoff = lds_byte(wr * 64 + fr, fq * 8), boff = lds_byte(wc * 32 + fr, fq * 8);
#define PG8_SA(b, h) (((b) * 2 + (h)) * HTB)
#define PG8_SB(b, h) ((4 + (b) * 2 + (h)) * HTB)
#define PG8_STAGE(bufoff, gbase, voff) do { _Pragma("unroll") for (int _i = 0; _i < 2; ++_i) \
        __builtin_amdgcn_global_load_lds((const unsigned*)((const char*)(gbase) + (voff)[_i]), (LAS unsigned*)(lds + (bufoff) + ldsw + _i * 8192), 16, 0, 0); } while (0)
#define PG8_LDA(dst, b, h) do { _Pragma("unroll") for (int m = 0; m < 4; ++m) _Pragma("unroll") for (int k = 0; k < 2; ++k) dst[m][k] = *(const LAS bf16x8*)(lds + PG8_SA(b, h) + aoff + m * 2048 + k * 1024); } while (0)
#define PG8_LDB(dst, b, h) do { _Pragma("unroll") for (int n = 0; n < 2; ++n) _Pragma("unroll") for (int k = 0; k < 2; ++k) dst[n][k] = *(const LAS bf16x8*)(lds + PG8_SB(b, h) + boff + n * 2048 + k * 1024); } while (0)
#define PG8_MMA(ai, bj, At, Bt) do { __builtin_amdgcn_s_setprio(1); _Pragma("unroll") for (int m = 0; m < 4; ++m) _Pragma("unroll") for (int n = 0; n < 2; ++n) _Pragma("unroll") for (int k = 0; k < 2; ++k) \
        acc[ai][bj][m][n] = __builtin_amdgcn_mfma_f32_16x16x32_bf16(Bt[n][k], At[m][k], acc[ai][bj][m][n], 0, 0, 0); __builtin_amdgcn_s_setprio(0); } while (0)
#define PG8_WAIT_V(n) asm volatile("s_waitcnt vmcnt(" #n ")" ::: "memory")
#define PG8_WAIT_L(n) asm volatile("s_waitcnt lgkmcnt(" #n ")" ::: "memory")
#define PG8_BAR __builtin_amdgcn_s_barrier()
#define PG8_SCHED __builtin_amdgcn_sched_barrier(0)
    Unit cur, nxt; int ui = 0;
    if (!S.next(0, cur)) return;
    Acc acc;
#pragma unroll
    for (int a = 0; a < 2; ++a)
#pragma unroll
        for (int b = 0; b < 2; ++b)
#pragma unroll
            for (int m = 0; m < 4; ++m)
#pragma unroll
                for (int n = 0; n < 2; ++n) acc[a][b][m][n] = (f32x4){0.f, 0.f, 0.f, 0.f};
    bf16x8 At[4][2], B0[2][2], B1[2][2];
    const char* cA = (const char*)g.A + (size_t)cur.pm * tstepA + (size_t)cur.pn * g.apn; const char* cB = (const char*)g.Bt + (size_t)cur.pn * tstepB;
    PG8_STAGE(PG8_SB(0, 0), cB, voffB); PG8_STAGE(PG8_SB(0, 1), cB + hstepB, voffB); PG8_STAGE(PG8_SA(0, 0), cA, voffA); PG8_STAGE(PG8_SA(0, 1), cA + hstepA, voffA);
    if (wr == 1) PG8_BAR;
    PG8_WAIT_V(2); PG8_BAR;
    PG8_STAGE(PG8_SB(1, 0), cB + kstep, voffB); PG8_STAGE(PG8_SA(1, 0), cA + kstep, voffA); PG8_STAGE(PG8_SB(1, 1), cB + hstepB + kstep, voffB);
    PG8_WAIT_V(6); PG8_BAR;
    for (;;) {
        const bool has_next = S.next(ui + 1, nxt);
        const char* nA = has_next ? (const char*)g.A + (size_t)nxt.pm * tstepA + (size_t)nxt.pn * g.apn : cA; const char* nB = has_next ? (const char*)g.Bt + (size_t)nxt.pn * tstepB : cB;
        const int nhalf_ = Epi::MID ? 2 : 1, tspan_ = nt / nhalf_;
#pragma unroll 1
        for (int hk = 0; hk < nhalf_; ++hk) {
        if constexpr (Epi::MID) { if (hk == 1) E.mid(acc, cur, wr, wc, fr, fq); }
#pragma unroll 1
        for (int t = hk * tspan_; t < (hk + 1) * tspan_; t += 2) {
            const bool last = (t == nt - 2);
            const char* aT = cA + (size_t)(t >> 1) * ak2;
            const char* a1 = aT + kstep;
            const char* a2 = last ? nA : aT + ak2; const char* b2 = last ? nB : cB + (size_t)(t + 2) * kstep;
            const char* a3 = a2 + kstep; const char* b3 = b2 + kstep;
            PG8_LDB(B0, 0, 0); PG8_LDB(B1, 0, 1); PG8_SCHED; PG8_LDA(At, 0, 0); PG8_STAGE(PG8_SA(1, 1), a1 + hstepA, voffA);
            PG8_WAIT_V(8); PG8_WAIT_L(0); PG8_BAR; PG8_MMA(0, 0, At, B0); PG8_MMA(0, 1, At, B1); PG8_BAR; PG8_SCHED;
            PG8_LDA(At, 0, 1); PG8_STAGE(PG8_SB(0, 0), b2, voffB); PG8_STAGE(PG8_SB(0, 1), b2 + hstepB, voffB); PG8_STAGE(PG8_SA(0, 0), a2, voffA);
            PG8_WAIT_V(8); PG8_WAIT_L(0); PG8_BAR; PG8_MMA(1, 0, At, B0); PG8_MMA(1, 1, At, B1); PG8_BAR; PG8_SCHED;
            PG8_LDB(B0, 1, 0); PG8_LDB(B1, 1, 1); PG8_SCHED; PG8_LDA(At, 1, 0); PG8_STAGE(PG8_SA(0, 1), a2 + hstepA, voffA);
            PG8_WAIT_V(8); PG8_WAIT_L(0); PG8_BAR; PG8_MMA(0, 0, At, B0); PG8_MMA(0, 1, At, B1); PG8_BAR; PG8_SCHED;
            PG8_LDA(At, 1, 1); PG8_STAGE(PG8_SB(1, 0), b3, voffB); PG8_STAGE(PG8_SB(1, 1), b3 + hstepB, voffB); PG8_STAGE(PG8_SA(1, 0), a3, voffA);
            PG8_WAIT_V(8); PG8_WAIT_L(0); PG8_BAR; PG8_MMA(1, 0, At, B0); PG8_MMA(1, 1, At, B1); PG8_BAR; PG8_SCHED;
        }
        }
        if (wr == 0) PG8_BAR;
        E(acc, cur, wr, wc, fr, fq);
        if (!has_next) break;
#pragma unroll
        for (int a = 0; a < 2; ++a)
#pragma unroll
            for (int b = 0; b < 2; ++b)
#pragma unroll
                for (int m = 0; m < 4; ++m)
#pragma unroll
                    for (int n = 0; n < 2; ++n) acc[a][b][m][n] = (f32x4){0.f, 0.f, 0.f, 0.f};
        cur = nxt; cA = nA; cB = nB; ++ui;
        if (wr == 1) PG8_BAR;
    }
    PG8_WAIT_V(0);
    PG8_BAR;
#undef PG8_SA
#undef PG8_SB
#undef PG8_STAGE
#undef PG8_LDA
#undef PG8_LDB
#undef PG8_MMA
#undef PG8_WAIT_V
#undef PG8_WAIT_L
#undef PG8_BAR
#undef PG8_SCHED
}

__device__ __forceinline__ u32x4 pack8(f32x4 v0, f32x4 v1) { u32x4 w; w.x = cvt_pk_bf16(v0[0], v0[1]); w.y = cvt_pk_bf16(v0[2], v0[3]); w.z = cvt_pk_bf16(v1[0], v1[1]); w.w = cvt_pk_bf16(v1[2], v1[3]); return w; }

template <bool SIDE> struct EpiBf16 {
    static constexpr bool PERM = true; static constexpr bool MID = false;
    bf16_t* O; int ldc; bf16_t* side;
    __device__ __forceinline__ void operator()(const Acc& acc, const Unit& u, int wr, int wc, int fr, int fq) const {
        const int row0 = u.pm * BM + wr * 64 + fr, col0 = u.pn * BM + wc * 32 + 8 * fq;
#pragma unroll
        for (int ai = 0; ai < 2; ++ai)
#pragma unroll
            for (int m = 0; m < 4; ++m) { const int row = row0 + ai * HALF + m * 16; bf16_t* rowp = O + (size_t)row * ldc + col0;
#pragma unroll
                for (int bj = 0; bj < 2; ++bj) { const u32x4 w = pack8(acc[ai][bj][m][0], acc[ai][bj][m][1]); *(u32x4*)(rowp + bj * HALF) = w;
                    if (SIDE && bj == 0) { const bool top = (fr == 0) && ((m & 1) == 0), bot = (fr == 15) && ((m & 1) == 1);
                        if (top || bot) *(u32x4*)(side + (size_t)((row >> 5) * 2 + (bot ? 1 : 0)) * DFF + u.pn * HALF + wc * 32 + 8 * fq) = w; } } }
    }
};
struct EpiF32 {
    static constexpr bool PERM = false; static constexpr bool MID = false;
    float* O; int ldc;
    __device__ __forceinline__ void operator()(const Acc& acc, const Unit& u, int wr, int wc, int fr, int fq) const {
        const int row0 = u.pm * BM + wr * 64 + fr, col0 = u.pn * BM + wc * 32 + 4 * fq;
#pragma unroll
        for (int ai = 0; ai < 2; ++ai)
#pragma unroll
            for (int m = 0; m < 4; ++m) { float* rowp = O + (size_t)(row0 + ai * HALF + m * 16) * ldc + col0;
#pragma unroll
                for (int bj = 0; bj < 2; ++bj)
#pragma unroll
                    for (int n = 0; n < 2; ++n) *(f32x4*)(rowp + bj * HALF + n * 16) = acc[ai][bj][m][n]; }
    }
};
template <int MODE> struct EpiGate {
    static constexpr bool PERM = true; static constexpr bool MID = false;
    const bf16_t* gates; bf16_t* T; bf16_t* OUT;
    __device__ __forceinline__ void operator()(const Acc& acc, const Unit& u, int wr, int wc, int fr, int fq) const {
        const int row0 = u.pm * BM + wr * 64 + fr, col0 = u.pn * BM + wc * 32 + 8 * fq;
#pragma unroll
        for (int ai = 0; ai < 2; ++ai)
#pragma unroll
            for (int m = 0; m < 4; ++m) { const size_t row = (size_t)(row0 + ai * HALF + m * 16);
#pragma unroll
                for (int bj = 0; bj < 2; ++bj) { const int col = col0 + bj * HALF;
                    const u32x4 gw = *(const u32x4*)(gates + row * 4096 + MODE * 2048 + col);
                    f32x4 v0 = acc[ai][bj][m][0], v1 = acc[ai][bj][m][1];
                    v0[0] *= bf_lo(gw.x); v0[1] *= bf_hi(gw.x); v0[2] *= bf_lo(gw.y); v0[3] *= bf_hi(gw.y);
                    v1[0] *= bf_lo(gw.z); v1[1] *= bf_hi(gw.z); v1[2] *= bf_lo(gw.w); v1[3] *= bf_hi(gw.w);
                    if (MODE == 1) { const u32x4 tw = *(const u32x4*)(T + row * DM + col);
                        v0[0] += bf_lo(tw.x); v0[1] += bf_hi(tw.x); v0[2] += bf_lo(tw.y); v0[3] += bf_hi(tw.y);
                        v1[0] += bf_lo(tw.z); v1[1] += bf_hi(tw.z); v1[2] += bf_lo(tw.w); v1[3] += bf_hi(tw.w);
                        *(u32x4*)(OUT + row * DM + col) = pack8(v0, v1);
                    } else *(u32x4*)(T + row * DM + col) = pack8(v0, v1); }
                asm volatile("" ::: "memory"); }
    }
};
struct EpiConv {
    static constexpr bool PERM = true; static constexpr bool MID = false;
    bf16_t* A; bf16_t* side; const float* cw; const float* cb; LAS unsigned char* scr;
    static __device__ __forceinline__ float ror1(float v) { return __int_as_float(__builtin_amdgcn_update_dpp(0, __float_as_int(v), 0x121, 0xF, 0xF, true)); }
    static __device__ __forceinline__ float ror15(float v) { return __int_as_float(__builtin_amdgcn_update_dpp(0, __float_as_int(v), 0x12F, 0xF, 0xF, true)); }
    static __device__ __forceinline__ float shr1_keep(float old, float v) { return __int_as_float(__builtin_amdgcn_update_dpp(__float_as_int(old), __float_as_int(v), 0x111, 0xF, 0xF, false)); }
    static __device__ __forceinline__ float shl1_keep(float old, float v) { return __int_as_float(__builtin_amdgcn_update_dpp(__float_as_int(old), __float_as_int(v), 0x101, 0xF, 0xF, false)); }
    __device__ __forceinline__ void operator()(const Acc& acc, const Unit& u, int wr, int wc, int fr_in, int fq_in) const {
        (void)fr_in; (void)fq_in; const int l_ = lane_id_volatile(); const int fr = l_ & 15, fq = l_ >> 4;
        int ch0 = u.pn * HALF + wc * 32 + 8 * fq, row0 = u.pm * BM + wr * 64 + fr;
        asm volatile("" : "+v"(ch0), "+v"(row0));
        const bool f0 = (fr == 0), f15 = (fr == 15);
#pragma unroll
        for (int n = 0; n < 2; ++n) {
            const int ch = ch0 + 4 * n;
            const f32x4 tg0 = *(const f32x4*)(cw + ch), tg1 = *(const f32x4*)(cw + UPC + ch), tg2 = *(const f32x4*)(cw + 2 * UPC + ch), tbg = *(const f32x4*)(cb + ch);
            const f32x4 tv0 = *(const f32x4*)(cw + DFF + ch), tv1 = *(const f32x4*)(cw + UPC + DFF + ch), tv2 = *(const f32x4*)(cw + 2 * UPC + DFF + ch), tbv = *(const f32x4*)(cb + DFF + ch);
#pragma unroll
            for (int ai = 0; ai < 2; ++ai) {
                LAS unsigned* mys = (LAS unsigned*)(scr + (wr * 4 + wc) * 2048 + l_ * 32);
#pragma unroll
                for (int j = 0; j < 4; ++j) {
                    const float wg0 = tg0[j], wg1 = tg1[j], wg2 = tg2[j], bg = tbg[j];
                    const float wv0 = tv0[j], wv1 = tv1[j], wv2 = tv2[j], bv = tbv[j];
                    float keep[4];
#pragma unroll
                    for (int m = 0; m < 4; ++m) {
                        const int mp = m > 0 ? m - 1 : 0, mn = m < 3 ? m + 1 : 3;
                        float g, v;
                        { const float g1a = ror1(acc[ai][0][mp][n][j]), g1b = ror1(acc[ai][0][m][n][j]), g5a = ror15(acc[ai][0][mn][n][j]), g5b = ror15(acc[ai][0][m][n][j]);
                          g = wg0 * (f0 ? g1a : g1b) + wg1 * acc[ai][0][m][n][j] + wg2 * (f15 ? g5a : g5b) + bg; }
                        __builtin_amdgcn_sched_barrier(0);
                        { const float v1a = ror1(acc[ai][1][mp][n][j]), v1b = ror1(acc[ai][1][m][n][j]), v5a = ror15(acc[ai][1][mn][n][j]), v5b = ror15(acc[ai][1][m][n][j]);
                          v = wv0 * (f0 ? v1a : v1b) + wv1 * acc[ai][1][m][n][j] + wv2 * (f15 ? v5a : v5b) + bv; }
                        keep[m] = gelu_tanh(g) * v;
                        __builtin_amdgcn_sched_barrier(0); }
#pragma unroll
                    for (int m = 0; m < 4; ++m) *(LAS bf16_t*)((LAS unsigned char*)mys + m * 8 + j * 2) = (bf16_t)(cvt_pk_bf16(keep[m], 0.f) & 0xffffu);
                    __builtin_amdgcn_sched_barrier(0);
                }
#pragma unroll
                for (int m = 0; m < 4; ++m) { const int row = row0 + ai * HALF + m * 16;
                    const bool edge = (m == 0 && f0) || (m == 3 && f15);
                    const u32x2 w = *(const LAS u32x2*)(mys + m * 2);
                    if (!edge) *(u32x2*)(A + (size_t)row * DFF + ch) = w;
                    const int idx = (m == 0) ? fr : fr - 12;
                    if ((m == 0 && fr < 2) || (m == 3 && fr >= 14)) { bf16_t* sp = side + ((size_t)(row >> 6) * 4 + idx) * UPC + ch;
                        u32x2 rg, rv; rg.x = cvt_pk_bf16(acc[ai][0][m][n][0], acc[ai][0][m][n][1]); rg.y = cvt_pk_bf16(acc[ai][0][m][n][2], acc[ai][0][m][n][3]);
                        rv.x = cvt_pk_bf16(acc[ai][1][m][n][0], acc[ai][1][m][n][1]); rv.y = cvt_pk_bf16(acc[ai][1][m][n][2], acc[ai][1][m][n][3]);
                        *(u32x2*)sp = rg; *(u32x2*)(sp + DFF) = rv; } }
                asm volatile("" ::: "memory"); __builtin_amdgcn_sched_barrier(0);
            }
        }
    }
};
struct EpiGateMid {
    static constexpr bool PERM = true; static constexpr bool MID = true;
    const bf16_t* gates; bf16_t* OUT;
    __device__ __forceinline__ void mid(Acc& acc, const Unit& u, int wr, int wc, int fr, int fq) const {
        int row0 = u.pm * BM + wr * 64 + fr, col0 = u.pn * BM + wc * 32 + 8 * fq;
        asm volatile("" : "+v"(row0), "+v"(col0));
#pragma unroll
        for (int ai = 0; ai < 2; ++ai) {
#pragma unroll
            for (int m = 0; m < 4; ++m) { const size_t row = (size_t)(row0 + ai * HALF + m * 16);
#pragma unroll
                for (int bj = 0; bj < 2; ++bj) { const int col = col0 + bj * HALF;
                    const u32x4 g0 = *(const u32x4*)(gates + row * 4096 + col), g1 = *(const u32x4*)(gates + row * 4096 + 2048 + col);
                    const unsigned a0[4] = {g0.x, g0.y, g0.z, g0.w}, a1[4] = {g1.x, g1.y, g1.z, g1.w};
#pragma unroll
                    for (int q = 0; q < 4; ++q) { const float r0 = bf_lo(a0[q]) * __builtin_amdgcn_rcpf(fmaxf(bf_lo(a1[q]), 1e-6f)), r1 = bf_hi(a0[q]) * __builtin_amdgcn_rcpf(fmaxf(bf_hi(a1[q]), 1e-6f));
                        acc[ai][bj][m][q >> 1][2 * (q & 1)] *= r0; acc[ai][bj][m][q >> 1][2 * (q & 1) + 1] *= r1; } }
                if (m & 1) { asm volatile("" ::: "memory"); __builtin_amdgcn_sched_barrier(0); } } }
    }
    __device__ __forceinline__ void operator()(const Acc& acc, const Unit& u, int wr, int wc, int fr, int fq) const {
        const int row0 = u.pm * BM + wr * 64 + fr, col0 = u.pn * BM + wc * 32 + 8 * fq;
#pragma unroll
        for (int ai = 0; ai < 2; ++ai)
#pragma unroll
            for (int m = 0; m < 4; ++m) { const size_t row = (size_t)(row0 + ai * HALF + m * 16);
#pragma unroll
                for (int bj = 0; bj < 2; ++bj) { const int col = col0 + bj * HALF;
                    const u32x4 gw = *(const u32x4*)(gates + row * 4096 + 2048 + col);
                    f32x4 v0 = acc[ai][bj][m][0], v1 = acc[ai][bj][m][1];
                    v0[0] *= fmaxf(bf_lo(gw.x), 1e-6f); v0[1] *= fmaxf(bf_hi(gw.x), 1e-6f); v0[2] *= fmaxf(bf_lo(gw.y), 1e-6f); v0[3] *= fmaxf(bf_hi(gw.y), 1e-6f);
                    v1[0] *= fmaxf(bf_lo(gw.z), 1e-6f); v1[1] *= fmaxf(bf_hi(gw.z), 1e-6f); v1[2] *= fmaxf(bf_lo(gw.w), 1e-6f); v1[3] *= fmaxf(bf_hi(gw.w), 1e-6f);
                    *(u32x4*)(OUT + row * DM + col) = pack8(v0, v1); }
                asm volatile("" ::: "memory"); }
    }
};
struct EpiZ {
    static constexpr bool PERM = true; static constexpr bool MID = false;
    bf16_t* qk; bf16_t* vt; bf16_t* pz; bf16_t* gates; const float* bgate; float qscale;
    __device__ __forceinline__ void operator()(const Acc& acc, const Unit& u, int wr, int wc, int fr, int fq) const {
        const int row0 = u.pm * BM + wr * 64 + fr, cl = wc * 32 + 8 * fq;
        if (u.pn < 8) {
            const float sc = (u.pn < 4) ? qscale : 1.0f;
#pragma unroll
            for (int ai = 0; ai < 2; ++ai)
#pragma unroll
                for (int m = 0; m < 4; ++m) { bf16_t* rowp = qk + (size_t)(row0 + ai * HALF + m * 16) * 2048 + u.pn * BM + cl;
#pragma unroll
                    for (int bj = 0; bj < 2; ++bj) *(u32x4*)(rowp + bj * HALF) = pack8(acc[ai][bj][m][0] * sc, acc[ai][bj][m][1] * sc); }
        } else if (u.pn < 12) {
            const int b = u.pm >> 4, s0 = (u.pm & 15) * BM + wr * 64 + fr;
#pragma unroll
            for (int bj = 0; bj < 2; ++bj) { const int h = 2 * (u.pn - 8) + bj;
#pragma unroll
                for (int n = 0; n < 2; ++n)
#pragma unroll
                    for (int j = 0; j < 4; ++j) { bf16_t* base = vt + ((size_t)((b * NH + h) * 128 + cl + 4 * n + j)) * SEQ + s0;
#pragma unroll
                        for (int ai = 0; ai < 2; ++ai)
#pragma unroll
                            for (int m = 0; m < 4; ++m) base[ai * HALF + m * 16] = (bf16_t)(cvt_pk_bf16(acc[ai][bj][m][n][j], 0.f) & 0xffffu);
                        asm volatile("" ::: "memory"); } }
        } else if (u.pn < 16) {
#pragma unroll
            for (int ai = 0; ai < 2; ++ai)
#pragma unroll
                for (int m = 0; m < 4; ++m) { bf16_t* rowp = pz + (size_t)(row0 + ai * HALF + m * 16) * 1024 + (u.pn - 12) * BM + cl;
#pragma unroll
                    for (int bj = 0; bj < 2; ++bj) *(u32x4*)(rowp + bj * HALF) = pack8(acc[ai][bj][m][0], acc[ai][bj][m][1]); }
        } else {
            const int gc = (u.pn - 16) * BM + cl;
#pragma unroll
            for (int bj = 0; bj < 2; ++bj) {
                const f32x4 b0 = *(const f32x4*)(bgate + gc + bj * HALF), b1 = *(const f32x4*)(bgate + gc + bj * HALF + 4);
#pragma unroll
                for (int ai = 0; ai < 2; ++ai)
#pragma unroll
                    for (int m = 0; m < 4; ++m) { bf16_t* rowp = gates + (size_t)(row0 + ai * HALF + m * 16) * 4096 + gc + bj * HALF;
                        f32x4 v0 = acc[ai][bj][m][0] + b0, v1 = acc[ai][bj][m][1] + b1;
#pragma unroll
                        for (int j = 0; j < 4; ++j) { v0[j] = sigmoidf_(v0[j]); v1[j] = sigmoidf_(v1[j]); }
                        *(u32x4*)rowp = pack8(v0, v1);
                        asm volatile("" ::: "memory"); __builtin_amdgcn_sched_barrier(0); } }
        }
    }
};
}

struct Args {
    const float* x; const float* g_pre_mix; const float* w_in; const float* b_gate;
    const float* lq1; const float* lk1; const float* lq2; const float* lk2; const float* subln;
    const float* w_attn; const float* pool_w; const float* pool_scale; const float* w_poolb; const float* w_out;
    const float* g_post_mix; const float* g_pre_ffn; const float* w_up; const float* conv_w; const float* conv_b;
    const float* w_down; const float* g_post_ffn;
    float* out; unsigned char* ws;
};

#ifndef PH_MASK
#define PH_MASK 0x3ff
#endif
#define PH(k) ((PH_MASK >> (k)) & 1)
constexpr int NTHR = 512, NWAVES = 8;
constexpr int LDS_BYTES = 147456 + 256;

__device__ __forceinline__ float wave_sum(float v) {
    const int l = lane_id_volatile();
#pragma unroll
    for (int o = 1; o < 64; o <<= 1) v += __int_as_float(__builtin_amdgcn_ds_bpermute((l ^ o) << 2, __float_as_int(v)));
    return v;
}

template <int MAP>
__device__ __forceinline__ void transpose_item(const float* W, int K, int N, bf16_t* WT, int ldd, LAS float* scr, int item, int lane) {
    const int nblk = N / 32, kb = item / nblk, nb = item % nblk, k0 = 64 * kb, n0 = 32 * nb;
#pragma unroll 8
    for (int i = 0; i < 32; ++i) { const int kk = 2 * i + (lane >> 5); scr[kk * 33 + (lane & 31)] = __builtin_nontemporal_load(W + (size_t)(k0 + kk) * N + n0 + (lane & 31)); }
    asm volatile("s_waitcnt lgkmcnt(0)" ::: "memory");
    int d0 = n0;
    if (MAP == 1) { const int half = n0 >= DFF ? 1 : 0, j = n0 - half * DFF; d0 = 256 * (j >> 7) + 128 * half + (j & 127); }
    const int c = lane & 7;
#pragma unroll
    for (int j = 0; j < 4; ++j) { const int n = (lane >> 3) + 8 * j; const LAS float* s = scr + (8 * c) * 33 + n;
        u32x4 o; o.x = cvt_pk_bf16(s[0 * 33], s[1 * 33]); o.y = cvt_pk_bf16(s[2 * 33], s[3 * 33]); o.z = cvt_pk_bf16(s[4 * 33], s[5 * 33]); o.w = cvt_pk_bf16(s[6 * 33], s[7 * 33]);
        *(u32x4*)(WT + (size_t)(d0 + n) * ldd + k0 + 8 * c) = o; }
    asm volatile("s_waitcnt lgkmcnt(0)" ::: "memory");
}

__device__ __forceinline__ void rms_row_bf16(const float* xrow, const float* g, bf16_t* orow, int lane) {
    f32x4 v[8]; float s = 0.f;
#pragma unroll
    for (int j = 0; j < 8; ++j) { v[j] = __builtin_nontemporal_load((const f32x4*)(xrow + 256 * j + 4 * lane)); s += (v[j][0] * v[j][0] + v[j][1] * v[j][1]) + (v[j][2] * v[j][2] + v[j][3] * v[j][3]); }
    const float rs = 1.0f / sqrtf(wave_sum(s) * (1.0f / DM) + NORM_EPS);
#pragma unroll
    for (int j = 0; j < 8; ++j) { const f32x4 gg = *(const f32x4*)(g + 256 * j + 4 * lane); const f32x4 o = v[j] * rs * gg;
        u32x2 w; w.x = cvt_pk_bf16(o[0], o[1]); w.y = cvt_pk_bf16(o[2], o[3]); *(u32x2*)(orow + 256 * j + 4 * lane) = w; }
}

constexpr int KPITCH = 144;
constexpr int KS_BYTES = 64 * KPITCH, VS_BYTES = 128 * KPITCH, ABUF = KS_BYTES + VS_BYTES;

__device__ __forceinline__ float swap_max(float v) { auto rr = __builtin_amdgcn_permlane32_swap(__float_as_uint(v), __float_as_uint(v), false, false); return fmaxf(__uint_as_float(rr[0]), __uint_as_float(rr[1])); }
__device__ __forceinline__ float swap_sum(float v) { auto rr = __builtin_amdgcn_permlane32_swap(__float_as_uint(v), __float_as_uint(v), false, false); return __uint_as_float(rr[0]) + __uint_as_float(rr[1]); }

__device__ __forceinline__ void attn_unit(LAS unsigned char* lds, const bf16_t* __restrict__ qk, const bf16_t* __restrict__ vt, bf16_t* __restrict__ opm,
                                          const float* __restrict__ subln, int b, int h, int qb, float lam, float c2, int wave0) {
    int tid_ = MY_TID(wave0); asm volatile("" : "+v"(tid_));
    const int tid = tid_, lane = tid & 63, ql = lane & 31, hi = lane >> 5; const int wid = __builtin_amdgcn_readfirstlane(tid >> 6);
    const int qpos = qb * 256 + wid * 32 + ql;
    __attribute__((address_space(1))) const float* subln_ = (__attribute__((address_space(1))) const float*)subln; asm volatile("" : "+s"(subln_));
    const size_t rowbase = (size_t)b * SEQ;
    const int kr = tid >> 3, kc = tid & 7;
    const bf16_t* vsrc0 = vt + ((size_t)((b * NH + h) * 128 + (tid >> 3))) * SEQ + kc * 8;
    const bf16_t* vsrc1 = vsrc0 + (size_t)64 * SEQ;
    const int kdst = kr * KPITCH + kc * 16, vdst0 = KS_BYTES + (tid >> 3) * KPITCH + kc * 16, vdst1 = vdst0 + 64 * KPITCH;
    const int pirow = 16 * (ql >> 4) + 8 * ((ql >> 2) & 1) + 4 * ((ql >> 3) & 1) + (ql & 3);
    const int kfo = pirow * KPITCH + hi * 16;
    const int vfo = KS_BYTES + ql * KPITCH + hi * 16;
    constexpr int RV = 3 * KS_BYTES, RO = RV + 3 * VS_BYTES;
    const int vdstr0 = (tid >> 3) * KPITCH + kc * 16, vdstr1 = vdstr0 + 64 * KPITCH, vfr = ql * KPITCH + hi * 16;
    const int qoff = RO + wid * 4096 + lane * 16;
#pragma unroll 1
    for (int c = 0; c < 2; ++c) {
        const bf16_t* qrow = qk + (rowbase + qpos) * 2048 + h * 128 + c * 64 + hi * 8;
        bf16x8 qf[4];
#pragma unroll
        for (int dd = 0; dd < 4; ++dd) qf[dd] = *(const bf16x8*)(qrow + dd * 16);
        const bf16_t* ksrc = qk + (rowbase + kr) * 2048 + 1024 + h * 128 + c * 64 + kc * 8;
        f32x16 O[4];
#pragma unroll
        for (int db = 0; db < 4; ++db)
#pragma unroll
            for (int r = 0; r < 16; ++r) O[db][r] = 0.f;
        float mrun = -1e30f, lrun = 0.f;
#pragma unroll
        for (int dd = 0; dd < 4; ++dd) *(LAS bf16x8*)(lds + qoff + dd * 1024) = qf[dd];
        u32x4 kR, vR0, vR1;
        { const u32x4 k0_ = *(const u32x4*)ksrc, v0_ = *(const u32x4*)vsrc0, v1_ = *(const u32x4*)vsrc1;
          *(LAS u32x4*)(lds + kdst) = k0_; *(LAS u32x4*)(lds + RV + vdstr0) = v0_; *(LAS u32x4*)(lds + RV + vdstr1) = v1_; }
        __builtin_amdgcn_sched_barrier(0);
        kR = *(const u32x4*)(ksrc + (size_t)64 * 2048); vR0 = *(const u32x4*)(vsrc0 + 64); vR1 = *(const u32x4*)(vsrc1 + 64);
        __syncthreads();
#define PBAR() do { asm volatile("s_waitcnt lgkmcnt(0)" ::: "memory"); __builtin_amdgcn_s_barrier(); asm volatile("" ::: "memory"); } while (0)
        const bool lag = (wid >= 4);
        if (lag) PBAR();
        f32x16 s0, s1; bf16x8 pf_[4];
#define QKT(slot) do { const int kcur_ = (slot) * KS_BYTES; \
            _Pragma("unroll") for (int r = 0; r < 16; ++r) { s0[r] = 0.f; s1[r] = 0.f; } \
            _Pragma("unroll") for (int dd = 0; dd < 4; ++dd) { \
                const bf16x8 qp_ = *(const LAS bf16x8*)(lds + qoff + dd * 1024); \
                const bf16x8 kf0_ = *(const LAS bf16x8*)(lds + kcur_ + kfo + dd * 32), kf1_ = *(const LAS bf16x8*)(lds + kcur_ + kfo + 32 * KPITCH + dd * 32); \
                __builtin_amdgcn_sched_barrier(0); \
                s0 = __builtin_amdgcn_mfma_f32_32x32x16_bf16(kf0_, qp_, s0, 0, 0, 0); s1 = __builtin_amdgcn_mfma_f32_32x32x16_bf16(kf1_, qp_, s1, 0, 0, 0); \
                __builtin_amdgcn_sched_barrier(0); } } while (0)
#define PVM(slot) do { const int vcur_ = RV + (slot) * VS_BYTES; \
            _Pragma("unroll") for (int g = 0; g < 4; ++g) { \
                bf16x8 vf_[4]; \
                _Pragma("unroll") for (int i = 0; i < 4; ++i) vf_[i] = *(const LAS bf16x8*)(lds + vcur_ + vfr + (2 * (g >> 1) + (i & 1)) * 32 * KPITCH + (2 * (g & 1) + (i >> 1)) * 32); \
                __builtin_amdgcn_sched_barrier(0); \
                _Pragma("unroll") for (int i = 0; i < 4; ++i) O[2 * (g >> 1) + (i & 1)] = __builtin_amdgcn_mfma_f32_32x32x16_bf16(vf_[i], pf_[2 * (g & 1) + (i >> 1)], O[2 * (g >> 1) + (i & 1)], 0, 0, 0); \
                __builtin_amdgcn_sched_barrier(0); } } while (0)
#define VLD(dst, g) do { _Pragma("unroll") for (int i = 0; i < 4; ++i) dst[i] = *(const LAS bf16x8*)(lds + vcur_ + vfr + (2 * ((g) >> 1) + (i & 1)) * 32 * KPITCH + (2 * ((g) & 1) + (i >> 1)) * 32); } while (0)
#define VMM(src, g) do { _Pragma("unroll") for (int i = 0; i < 4; ++i) O[2 * ((g) >> 1) + (i & 1)] = __builtin_amdgcn_mfma_f32_32x32x16_bf16(src[i], pf_[2 * ((g) & 1) + (i >> 1)], O[2 * ((g) >> 1) + (i & 1)], 0, 0, 0); } while (0)
#define KLD(kd, qd, h2) do { _Pragma("unroll") for (int d2 = 0; d2 < 2; ++d2) { const int dd = 2 * (h2) + d2; qd[d2] = *(const LAS bf16x8*)(lds + qoff + dd * 1024); \
            kd[2 * d2] = *(const LAS bf16x8*)(lds + kcur_ + kfo + dd * 32); kd[2 * d2 + 1] = *(const LAS bf16x8*)(lds + kcur_ + kfo + 32 * KPITCH + dd * 32); } } while (0)
#define KMM(kd, qd) do { _Pragma("unroll") for (int d2 = 0; d2 < 2; ++d2) { s0 = __builtin_amdgcn_mfma_f32_32x32x16_bf16(kd[2 * d2], qd[d2], s0, 0, 0, 0); s1 = __builtin_amdgcn_mfma_f32_32x32x16_bf16(kd[2 * d2 + 1], qd[d2], s1, 0, 0, 0); } } while (0)
#define SB() __builtin_amdgcn_sched_barrier(0)
#define APHASE(vslot, kslot, DOPV, DOQK) do { const int vcur_ = RV + (vslot) * VS_BYTES, kcur_ = (kslot) * KS_BYTES; \
            bf16x8 ga_[4], gb_[4], ka_[4], qa_[2], kb_[4], qb_[2]; \
            if (DOPV) { VLD(ga_, 0); VLD(gb_, 1); SB(); VMM(ga_, 0); SB(); VLD(ga_, 2); SB(); VMM(gb_, 1); SB(); VLD(gb_, 3); SB(); VMM(ga_, 2); SB(); } \
            if (DOQK) { KLD(ka_, qa_, 0); SB(); } \
            if (DOPV) { VMM(gb_, 3); SB(); } \
            if (DOQK) { KLD(kb_, qb_, 1); SB(); \
                _Pragma("unroll") for (int r = 0; r < 16; ++r) { s0[r] = 0.f; s1[r] = 0.f; } \
                KMM(ka_, qa_); SB(); KMM(kb_, qb_); SB(); } } while (0)
#define SOFTMAX(t) do { \
            const float base_ = (float)((t) * 64 + 8 * hi - qpos); \
            float mx_ = -1e30f; \
            { float x0_ = base_, x1_ = base_ + 32.0f; \
              _Pragma("unroll") for (int r = 0; r < 16; ++r) { \
                if (r == 8) { x0_ = base_ + 16.0f; x1_ = base_ + 48.0f; } \
                s0[r] = s0[r] - c2 * fabsf(x0_); s1[r] = s1[r] - c2 * fabsf(x1_); \
                mx_ = fmaxf(mx_, fmaxf(s0[r], s1[r])); x0_ += 1.0f; x1_ += 1.0f; } } \
            mx_ = swap_max(mx_); \
            __builtin_amdgcn_sched_barrier(0); \
            const float mnew_ = fmaxf(mrun, mx_); \
            if (__any(mnew_ > mrun)) { \
                const float alpha_ = __builtin_amdgcn_exp2f(mrun - mnew_); lrun *= alpha_; \
                _Pragma("unroll") for (int db = 0; db < 4; ++db) _Pragma("unroll") for (int r = 0; r < 16; ++r) O[db][r] *= alpha_; \
                mrun = mnew_; } \
            __builtin_amdgcn_sched_barrier(0); \
            float ls_ = 0.f; \
            _Pragma("unroll") for (int r = 0; r < 16; ++r) { s0[r] = __builtin_amdgcn_exp2f(s0[r] - mrun); s1[r] = __builtin_amdgcn_exp2f(s1[r] - mrun); ls_ += s0[r] + s1[r]; } \
            lrun += ls_; \
            __builtin_amdgcn_sched_barrier(0); \
            { u32x4 w_; \
              w_.x = cvt_pk_bf16(s0[0], s0[1]); w_.y = cvt_pk_bf16(s0[2], s0[3]); w_.z = cvt_pk_bf16(s0[4], s0[5]); w_.w = cvt_pk_bf16(s0[6], s0[7]); pf_[0] = __builtin_bit_cast(bf16x8, w_); \
              w_.x = cvt_pk_bf16(s0[8], s0[9]); w_.y = cvt_pk_bf16(s0[10], s0[11]); w_.z = cvt_pk_bf16(s0[12], s0[13]); w_.w = cvt_pk_bf16(s0[14], s0[15]); pf_[1] = __builtin_bit_cast(bf16x8, w_); \
              w_.x = cvt_pk_bf16(s1[0], s1[1]); w_.y = cvt_pk_bf16(s1[2], s1[3]); w_.z = cvt_pk_bf16(s1[4], s1[5]); w_.w = cvt_pk_bf16(s1[6], s1[7]); pf_[2] = __builtin_bit_cast(bf16x8, w_); \
              w_.x = cvt_pk_bf16(s1[8], s1[9]); w_.y = cvt_pk_bf16(s1[10], s1[11]); w_.z = cvt_pk_bf16(s1[12], s1[13]); w_.w = cvt_pk_bf16(s1[14], s1[15]); pf_[3] = __builtin_bit_cast(bf16x8, w_); } \
            __builtin_amdgcn_sched_barrier(0); } while (0)
#define STAGE_WRITE(slot) do { *(LAS u32x4*)(lds + (slot) * KS_BYTES + kdst) = kR; *(LAS u32x4*)(lds + RV + (slot) * VS_BYTES + vdstr0) = vR0; *(LAS u32x4*)(lds + RV + (slot) * VS_BYTES + vdstr1) = vR1; } while (0)
        APHASE(0, 0, false, true); STAGE_WRITE(1); PBAR();
        int sc = 0, sn = 1, sw = 2;
#pragma unroll 1
        for (int t = 0; t < 63; ++t) {
            if (t + 2 < 64) { kR = *(const u32x4*)(ksrc + (size_t)(t + 2) * 64 * 2048); vR0 = *(const u32x4*)(vsrc0 + (t + 2) * 64); vR1 = *(const u32x4*)(vsrc1 + (t + 2) * 64); }
            SOFTMAX(t); PBAR();
            APHASE(sc, sn, true, true);
            if (t + 2 < 64) STAGE_WRITE(sw);
            PBAR();
            { const int t_ = sc; sc = sn; sn = sw; sw = t_; }
        }
        SOFTMAX(63); PBAR();
        APHASE(sc, 0, true, false); PBAR();
        if (!lag) PBAR();
#undef STAGE_WRITE
#undef SOFTMAX
#undef PVM
#undef APHASE
#undef VLD
#undef VMM
#undef KLD
#undef KMM
#undef SB
#undef QKT
#undef PBAR
        const float inv = 1.0f / swap_sum(lrun);
        bf16_t* orow = opm + (rowbase + qpos) * 2048 + h * 128 + 4 * hi;
        if (c == 0) {
#pragma unroll
            for (int db = 0; db < 4; ++db)
#pragma unroll
                for (int g = 0; g < 4; ++g) { u32x2 w; w.x = cvt_pk_bf16(O[db][4 * g] * inv, O[db][4 * g + 1] * inv); w.y = cvt_pk_bf16(O[db][4 * g + 2] * inv, O[db][4 * g + 3] * inv);
                    *(u32x2*)(orow + 32 * db + 8 * g) = w; }
        } else {
            float ss = 0.f;
#pragma unroll
            for (int db = 0; db < 4; ++db) {
#pragma unroll
                for (int g = 0; g < 4; ++g) { const u32x2 w = *(const u32x2*)(orow + 32 * db + 8 * g); const int r = 4 * g;
                    const float a0 = bf_lo(w.x) - lam * (O[db][r] * inv), a1 = bf_hi(w.x) - lam * (O[db][r + 1] * inv), a2 = bf_lo(w.y) - lam * (O[db][r + 2] * inv), a3 = bf_hi(w.y) - lam * (O[db][r + 3] * inv);
                    O[db][r] = a0; O[db][r + 1] = a1; O[db][r + 2] = a2; O[db][r + 3] = a3; ss = fmaf(a0, a0, ss); ss = fmaf(a1, a1, ss); ss = fmaf(a2, a2, ss); ss = fmaf(a3, a3, ss);
                    asm volatile("" : "+v"(ss)); __builtin_amdgcn_sched_barrier(0); } }
            ss = swap_sum(ss);
            const float rn = (1.0f - LAMBDA_INIT) / sqrtf(ss * (1.0f / 128.0f) + SUBLN_EPS);
#pragma unroll
            for (int db = 0; db < 4; ++db)
#pragma unroll
                for (int g = 0; g < 4; ++g) { const int d = 32 * db + 8 * g;
                    const f32x4 gn = *(const f32x4*)(subln_ + d + 4 * hi);
                    u32x2 w; w.x = cvt_pk_bf16(O[db][4 * g] * rn * gn[0], O[db][4 * g + 1] * rn * gn[1]); w.y = cvt_pk_bf16(O[db][4 * g + 2] * rn * gn[2], O[db][4 * g + 3] * rn * gn[3]);
                    *(u32x2*)(orow + d) = w; }
        }
    }
}

#if defined(DBG_STOP)
__device__ __forceinline__ void dbg_dump(const Args& a, int k) {
    const size_t gt = (size_t)blockIdx.x * NTHR + threadIdx.x, NGT = (size_t)gridDim.x * NTHR;
    const bf16_t* b16 = (const bf16_t*)a.ws;
    for (size_t i = gt; i < (size_t)M * DM; i += NGT) {
        const size_t row = i / DM, col = i % DM; float v = 0.f;
        auto B = [&](size_t off, size_t idx) { return __uint_as_float((unsigned)((const bf16_t*)(a.ws + off))[idx] << 16); };
        if (k == 0) { v = B(WS_WIN, i % ((size_t)8192 * 2048)); }
        if (k == 1 && DBG_SEL == 1) { v = B(WS_GATES, row * 4096 + col) + B(WS_GATES, row * 4096 + 2048 + col); }
        if (k == 1 && DBG_SEL == 3) { v = B(WS_QK, i); }
        if (k == 1 && DBG_SEL == 4) { v = B(WS_PZ, row * 1024 + (col & 1023)) + B(WS_VT, row * 1024 + (col & 1023)); }
        if (k == 1 && DBG_SEL == 2) { v = B(WS_WCAT, i % ((size_t)2048 * 2048)); }
        if (k == 1 && DBG_SEL == 0) { v = B(WS_QK, i) + B(WS_PZ, row * 1024 + (col & 1023)) + B(WS_VT, row * 1024 + (col & 1023)) + B(WS_GATES, row * 4096 + col) + B(WS_GATES, row * 4096 + 2048 + col) + B(WS_WCAT, i % ((size_t)2048 * 2048)); }
        if (k == 2) { v = B(WS_OPM, i); }
        if (k == 3) { v = B(WS_MERGED, i) + B(WS_T, i); }
        if (k == 4) { v = ((const float*)(a.ws + WS_MO))[i]; }
        if (k == 5) { v = a.out[i] + B(WS_H2, i); }
        if (k == 6) { v = B(WS_U, row * UPC + col) + B(WS_U, row * UPC + 2048 + col) + B(WS_U, row * UPC + 4096 + col) + B(WS_U, row * UPC + 6144 + col) + B(WS_U, row * UPC + 8192 + col) + B(WS_U, row * UPC + 9216 + col) + B(WS_SIDE, i % ((size_t)1024 * 5632)); }
        if (k == 7) { v = B(WS_U, row * UPC + col) + B(WS_U, row * UPC + 2048 + col) + B(WS_U, row * UPC + 4096 + col) + B(WS_U, row * UPC + 6144 + col) + B(WS_U, row * UPC + 8192 + col) + B(WS_U, row * UPC + 9216 + col); }
        if (k == 8) { v = ((const float*)(a.ws + WS_Y))[i]; }
        a.out[i] = v;
    }
}
#endif

#define XB_TMO      128
#define XB_XCNT(j)  (256  + 64 * (j))
#define XB_XSUB(j)  (1280 + 64 * (j))
#define XB_XGEN(j)  (2304 + 64 * (j))
#define XB_TOP      3328
#define XB_TOPGEN   3392
#define XCD_BAR_WORDS 3456
#define XB_SPIN_CAP (1u << 18)
__device__ __forceinline__ unsigned xb_ld(unsigned* p)              { return __hip_atomic_load(p, __ATOMIC_RELAXED, __HIP_MEMORY_SCOPE_AGENT); }
__device__ __forceinline__ unsigned xb_add(unsigned* p, unsigned v) { return __hip_atomic_fetch_add(p, v, __ATOMIC_RELAXED, __HIP_MEMORY_SCOPE_AGENT); }
__device__ __forceinline__ unsigned xb_xcc_id() { return (unsigned)__builtin_amdgcn_s_getreg((3 << 11) | 20) & 0xFu; }
#define XB_SPIN(cond, bar) do { unsigned _sp = 0; while (cond) { __builtin_amdgcn_s_sleep(1); \
    if ((++_sp & 255u) == 0u) { if (xb_ld(&(bar)[XB_TMO])) break; if (_sp > XB_SPIN_CAP) { atomicAdd(&(bar)[XB_TMO], 1u); break; } } } } while (0)
__device__ __forceinline__ void xcd_barrier_complete(unsigned* bar, unsigned x, unsigned& nloc, unsigned& nx) {
    const unsigned G = gridDim.x * gridDim.y * gridDim.z;
    unsigned sum, cnt, mine, sp = 0u;
    for (;;) {
        sum = 0u; cnt = 0u; mine = 0u;
#pragma unroll
        for (unsigned j = 0; j < 16; ++j) { const unsigned c = xb_ld(&bar[XB_XCNT(j)]); sum += c; cnt += (c > 0u) ? 1u : 0u; mine = (j == x) ? c : mine; }
        if (sum == G) break;
        __builtin_amdgcn_s_sleep(1);
        if ((++sp & 255u) == 0u) { if (xb_ld(&bar[XB_TMO])) break; if (sp > XB_SPIN_CAP) { atomicAdd(&bar[XB_TMO], 1u); break; } }
    }
    nloc = mine > 0u ? mine : 1u; nx = cnt > 0u ? cnt : 1u;
}
__device__ __forceinline__ void xcd_barrier(unsigned* bar, unsigned x, volatile LAS unsigned* st, bool tid0) {
    asm volatile("s_waitcnt vmcnt(0)" ::: "memory");
    __syncthreads();
    if (tid0) {
        __builtin_amdgcn_s_waitcnt(0);
        unsigned nloc = st[0], nx = st[1];
        if (nloc == 0u) { xcd_barrier_complete(bar, x, nloc, nx); st[0] = nloc; st[1] = nx; }
        const unsigned old = xb_add(&bar[XB_XSUB(x)], 1u);
        const unsigned gen = old / nloc;
        if (old + 1u == (gen + 1u) * nloc) {
            __builtin_amdgcn_fence(__ATOMIC_RELEASE, "agent");
            asm volatile("s_waitcnt vmcnt(0)" ::: "memory");
            const unsigned og = xb_add(&bar[XB_TOP], 1u);
            const unsigned tg = og / nx;
            if (og + 1u == (tg + 1u) * nx) xb_add(&bar[XB_TOPGEN], 1u);
            else XB_SPIN(xb_ld(&bar[XB_TOPGEN]) == tg, bar);
            __builtin_amdgcn_fence(__ATOMIC_ACQUIRE, "agent");
            xb_add(&bar[XB_XGEN(x)], 1u);
            asm volatile("s_waitcnt vmcnt(0)" ::: "memory");
        } else {
            XB_SPIN(xb_ld(&bar[XB_XGEN(x)]) == gen, bar);
            __builtin_amdgcn_fence(__ATOMIC_ACQUIRE, "agent");
            asm volatile("s_waitcnt vmcnt(0)" ::: "memory");
        }
    }
    __syncthreads();
}

__device__ unsigned g_bar[64];
__global__ void __launch_bounds__(NTHR, 2) fwd_kernel(Args a) {
    extern __shared__ __attribute__((aligned(16))) unsigned char lds_raw[];
    LAS unsigned char* lds = (LAS unsigned char*)lds_raw;
    cg::grid_group grid = cg::this_grid();
    const int G = gridDim.x, bx = blockIdx.x;
    const int wave0 = __builtin_amdgcn_readfirstlane((int)threadIdx.x >> 6);
    const int vcu = (G % 8 == 0) ? (bx % 8) * (G / 8) + bx / 8 : bx;
    const int NGW = G * NWAVES, NGT = G * NTHR;
    unsigned* const xb_bar = (unsigned*)(a.ws + WS_CTL);
    volatile LAS unsigned* const xb_st = (volatile LAS unsigned*)(lds + LDS_BYTES - 64);
    const unsigned xb_x = xb_xcc_id();
    if (MY_TID(wave0) == 0) { xb_st[0] = 0u; xb_st[1] = 0u; (void)xb_add(&xb_bar[XB_XCNT(xb_x)], 1u); }
    __syncthreads();
    if (a.ws == nullptr) grid.sync();
#define GRID_SYNC() xcd_barrier(xb_bar, xb_x, xb_st, MY_TID(wave0) == 0)
#define PHASE_VIEW() \
    int tid_ = MY_TID(wave0); asm volatile("" : "+v"(tid_)); const int tid = tid_, lane = tid & 63, wave = wave0; \
    const int gw = vcu * NWAVES + wave, gt = bx * NTHR + tid; (void)gw; (void)gt; (void)lane; \
    __attribute__((address_space(1))) unsigned char* ws = (__attribute__((address_space(1))) unsigned char*)a.ws; asm volatile("" : "+s"(ws));     \
    bf16_t* WdownT = (bf16_t*)(ws + WS_WDOWN); bf16_t* WinT = (bf16_t*)(ws + WS_WIN); bf16_t* WoutT = (bf16_t*)(ws + WS_WOUT); \
    bf16_t* WcatT = (bf16_t*)(ws + WS_WCAT); bf16_t* WpT = (bf16_t*)(ws + WS_WPT); bf16_t* PWs = (bf16_t*)(ws + WS_PWS); \
    bf16_t* Hb = (bf16_t*)(ws + WS_H); bf16_t* OPM = (bf16_t*)(ws + WS_OPM); bf16_t* QK = (bf16_t*)(ws + WS_QK); bf16_t* MERGED = (bf16_t*)(ws + WS_MERGED); \
    bf16_t* VT = (bf16_t*)(ws + WS_VT); bf16_t* PZ = (bf16_t*)(ws + WS_PZ); bf16_t* Tb = (bf16_t*)(ws + WS_T); bf16_t* GATES = (bf16_t*)(ws + WS_GATES); \
    float* MO = (float*)(ws + WS_MO); bf16_t* H2 = (bf16_t*)(ws + WS_H2); bf16_t* WupT = (bf16_t*)(ws + WS_WUP); bf16_t* U = (bf16_t*)(ws + WS_U); \
    bf16_t* SIDE = (bf16_t*)(ws + WS_SIDE); float* Y = (float*)(ws + WS_Y); \
    (void)WdownT; (void)WinT; (void)WoutT; (void)WcatT; (void)WpT; (void)PWs; (void)Hb; (void)OPM; (void)QK; (void)MERGED; (void)VT; (void)PZ; (void)Tb; (void)GATES; (void)MO; (void)H2; (void)WupT; (void)U; (void)SIDE; (void)Y;

    if (PH(0)) { PHASE_VIEW()
        LAS float* scr = (LAS float*)(lds + wave * 16384);
        constexpr int I_IN = (DM / 64) * (INC / 32), I_UP = (DM / 64) * (UPC / 32), I_DN = (DFF / 64) * (DM / 32), I_OUT = (DM / 64) * (DM / 32), I_AT = (1024 / 64) * (DM / 32), I_PB = I_AT;
        constexpr int NITEMS = I_IN + I_UP + I_DN + I_OUT + I_AT + I_PB;
        for (int it = gw; it < NITEMS; it += NGW) {
            int r = it;
            if (r < I_IN) { transpose_item<0>(a.w_in, DM, INC, WinT, DM, scr, r, lane); continue; } r -= I_IN;
            if (r < I_UP) { transpose_item<1>(a.w_up, DM, UPC, WupT, DM, scr, r, lane); continue; } r -= I_UP;
            if (r < I_DN) { transpose_item<0>(a.w_down, DFF, DM, WdownT, DFF, scr, r, lane); continue; } r -= I_DN;
            if (r < I_OUT) { transpose_item<0>(a.w_out, DM, DM, WoutT, DM, scr, r, lane); continue; } r -= I_OUT;
            if (r < I_AT) { transpose_item<0>(a.w_attn, 1024, DM, WcatT, DM, scr, r, lane); continue; } r -= I_AT;
            transpose_item<0>(a.w_poolb, 1024, DM, WpT, 1024, scr, r, lane);
        }
        for (int i = gt; i < 1024 * 256 / 4; i += NGT) { const int e = i * 4, gcl = e >> 8, dp = e & 255, g = gcl >> 8;
            const f32x4 w = *(const f32x4*)(a.pool_w + e), sc = *(const f32x4*)(a.pool_scale + g * 256 + dp); const f32x4 o = w * sc;
            u32x2 p; p.x = cvt_pk_bf16(o[0], o[1]); p.y = cvt_pk_bf16(o[2], o[3]); *(u32x2*)(PWs + e) = p; }
        for (int m = gw; m < M; m += NGW) rms_row_bf16(a.x + (size_t)m * DM, a.g_pre_mix, Hb + (size_t)m * DM, lane);
    }
    GRID_SYNC();
#if defined(DBG_STOP)
    if (DBG_STOP == 0) { dbg_dump(a, 0); return; }
#endif

    if (PH(1)) { PHASE_VIEW()
#ifndef NO_MINI
        {
            pg8::Gemm gm{WpT, PWs, 1024, 256, 256, 256, 512};
            pg8::StaticOrder S; S.init(DM, 1024, G, bx);
            pg8::EpiBf16<false> E{WcatT + 1024, DM, nullptr};
            pg8::gemm_phase(lds, gm, S, E, wave0);
        }
#endif
#ifndef NO_Z
        pg8::Gemm gm{Hb, WinT, DM, DM, DM, 256, 0};
        pg8::StaticOrder S; S.init(M, INC, G, bx);
        pg8::EpiZ E{QK, VT, PZ, GATES, a.b_gate, 0.125f * LOG2E};
        pg8::gemm_phase(lds, gm, S, E, wave0);
#endif
    }
    GRID_SYNC();
#if defined(DBG_STOP)
    if (DBG_STOP == 1) { dbg_dump(a, 1); return; }
#endif

    if (PH(2)) { PHASE_VIEW()
        for (int i = gt; i < (M / 16) * 128; i += NGT) {
            const int vec = i & 127, rb = i >> 7, g = vec >> 5, half = 1 << g, row0 = rb * 16, s0 = row0 & (SEQ - 1);
            const bf16_t* base = PZ + (size_t)(row0 - s0) * 1024 + vec * 8;
            bf16_t* outp = OPM + (size_t)row0 * 2048 + 1024 + vec * 8;
            int lo = (s0 - half < 0) ? 0 : s0 - half, hi_ = (s0 + half > SEQ) ? SEQ : s0 + half;
            float acc[8];
#pragma unroll
            for (int j = 0; j < 8; ++j) acc[j] = 0.f;
            for (int r = lo; r < hi_; ++r) { const u32x4 w = *(const u32x4*)(base + (size_t)r * 1024);
                acc[0] += bf_lo(w.x); acc[1] += bf_hi(w.x); acc[2] += bf_lo(w.y); acc[3] += bf_hi(w.y); acc[4] += bf_lo(w.z); acc[5] += bf_hi(w.z); acc[6] += bf_lo(w.w); acc[7] += bf_hi(w.w); }
#pragma unroll 4
            for (int k = 0; k < 16; ++k) {
                const int s = s0 + k;
                const u32x4 w = *(const u32x4*)(base + (size_t)s * 1024);
                const float ic = 1.0f / (float)(hi_ - lo);
                u32x4 o;
                o.x = cvt_pk_bf16(acc[0] * ic - bf_lo(w.x), acc[1] * ic - bf_hi(w.x)); o.y = cvt_pk_bf16(acc[2] * ic - bf_lo(w.y), acc[3] * ic - bf_hi(w.y));
                o.z = cvt_pk_bf16(acc[4] * ic - bf_lo(w.z), acc[5] * ic - bf_hi(w.z)); o.w = cvt_pk_bf16(acc[6] * ic - bf_lo(w.w), acc[7] * ic - bf_hi(w.w));
                *(u32x4*)(outp + (size_t)k * 2048) = o;
                if (s - half >= 0) { const u32x4 q = *(const u32x4*)(base + (size_t)(s - half) * 1024);
                    acc[0] -= bf_lo(q.x); acc[1] -= bf_hi(q.x); acc[2] -= bf_lo(q.y); acc[3] -= bf_hi(q.y); acc[4] -= bf_lo(q.z); acc[5] -= bf_hi(q.z); acc[6] -= bf_lo(q.w); acc[7] -= bf_hi(q.w); ++lo; }
                if (s + half < SEQ) { const u32x4 q = *(const u32x4*)(base + (size_t)(s + half) * 1024);
                    acc[0] += bf_lo(q.x); acc[1] += bf_hi(q.x); acc[2] += bf_lo(q.y); acc[3] += bf_hi(q.y); acc[4] += bf_lo(q.z); acc[5] += bf_hi(q.z); acc[6] += bf_lo(q.w); acc[7] += bf_hi(q.w); ++hi_; }
            }
        }
        const float d1 = wave_sum(a.lq1[lane] * a.lk1[lane]), d2 = wave_sum(a.lq2[lane] * a.lk2[lane]);
        const float lam = expf(d1) - expf(d2) + LAMBDA_INIT;
        for (int uidx = vcu; uidx < NB * NH * 16; uidx += G) {
            const int bh = uidx >> 4, qb = uidx & 15, b = bh >> 3, h = bh & 7;
            const float c2 = exp2f(-(float)(h + 1)) * LOG2E;
            attn_unit(lds, QK, VT, OPM, a.subln, b, h, qb, lam, c2, wave0);
        }
    }
    GRID_SYNC();
#if defined(DBG_STOP)
    if (DBG_STOP == 2) { dbg_dump(a, 2); return; }
#endif

    if (PH(3)) { PHASE_VIEW()
        pg8::StaticOrder S; S.init(M, DM, G, bx);
        { pg8::Gemm gm{OPM, WcatT, DM, DM, DM, 256, 0}; pg8::EpiGateMid E{GATES, MERGED}; pg8::gemm_phase(lds, gm, S, E, wave0); }
    }
    GRID_SYNC();
#if defined(DBG_STOP)
    if (DBG_STOP == 3) { dbg_dump(a, 3); return; }
#endif

    if (PH(4)) { PHASE_VIEW()
        pg8::Gemm gm{MERGED, WoutT, DM, DM, DM, 256, 0}; pg8::StaticOrder S; S.init(M, DM, G, bx);
        pg8::EpiF32 E{MO, DM}; pg8::gemm_phase(lds, gm, S, E, wave0);
    }
    GRID_SYNC();
#if defined(DBG_STOP)
    if (DBG_STOP == 4) { dbg_dump(a, 4); return; }
#endif

    if (PH(5)) { PHASE_VIEW()
    for (int m = gw; m < M; m += NGW) {
        const float* mor = MO + (size_t)m * DM; const float* xr = a.x + (size_t)m * DM; float* o = a.out + (size_t)m * DM; bf16_t* h2r = H2 + (size_t)m * DM;
        f32x4 v[8]; float s = 0.f;
#pragma unroll
        for (int j = 0; j < 8; ++j) { v[j] = __builtin_nontemporal_load((const f32x4*)(mor + 256 * j + 4 * lane)); s += (v[j][0] * v[j][0] + v[j][1] * v[j][1]) + (v[j][2] * v[j][2] + v[j][3] * v[j][3]); }
        const float rs = 1.0f / sqrtf(wave_sum(s) * (1.0f / DM) + NORM_EPS);
        float s2 = 0.f;
#pragma unroll
        for (int j = 0; j < 8; ++j) { const f32x4 gg = *(const f32x4*)(a.g_post_mix + 256 * j + 4 * lane), xx = __builtin_nontemporal_load((const f32x4*)(xr + 256 * j + 4 * lane));
            v[j] = xx + v[j] * rs * gg; *(f32x4*)(o + 256 * j + 4 * lane) = v[j];
            s2 += (v[j][0] * v[j][0] + v[j][1] * v[j][1]) + (v[j][2] * v[j][2] + v[j][3] * v[j][3]); }
        const float rs2 = 1.0f / sqrtf(wave_sum(s2) * (1.0f / DM) + NORM_EPS);
#pragma unroll
        for (int j = 0; j < 8; ++j) { const f32x4 gg = *(const f32x4*)(a.g_pre_ffn + 256 * j + 4 * lane); const f32x4 q = v[j] * rs2 * gg;
            u32x2 w; w.x = cvt_pk_bf16(q[0], q[1]); w.y = cvt_pk_bf16(q[2], q[3]); *(u32x2*)(h2r + 256 * j + 4 * lane) = w; }
    } }
    GRID_SYNC();
#if defined(DBG_STOP)
    if (DBG_STOP == 5) { dbg_dump(a, 5); return; }
#endif

    if (PH(6)) { PHASE_VIEW()
        pg8::Gemm gm{H2, WupT, DM, DM, DM, 256, 0}; pg8::StaticOrder S; S.init(M, UPC, G, bx);
        pg8::EpiConv E{U, SIDE, a.conv_w, a.conv_b, lds + pg8::STAGE_BYTES}; pg8::gemm_phase(lds, gm, S, E, wave0);
    }
    GRID_SYNC();
#if defined(DBG_STOP)
    if (DBG_STOP == 6) { dbg_dump(a, 6); return; }
#endif

    if (PH(7)) { PHASE_VIEW()
    for (int it = gt; it < 256 * 2 * 704; it += NGT) {
        const int v8 = it % 704, which = (it / 704) & 1, k = it / 1408, ch = 8 * v8;
        const int r = which ? 64 * k + 63 : 64 * k;
        const bool seq_first = (r & (SEQ - 1)) == 0, seq_last = ((r + 1) & (SEQ - 1)) == 0;
        const bf16_t* sk = SIDE + (size_t)k * 4 * UPC + ch;
        const bf16_t* pp = which ? sk + 2 * UPC : (seq_first ? sk : sk - UPC);
        const bf16_t* pc = which ? sk + 3 * UPC : sk;
        const bf16_t* pn = which ? (seq_last ? sk : sk + 4 * UPC) : sk + UPC;
        const bool zp = (!which) && seq_first, zn = which && seq_last;
        const u32x4 z4 = {0u, 0u, 0u, 0u};
        u32x4 gp = *(const u32x4*)pp, gc = *(const u32x4*)pc, gn = *(const u32x4*)pn, vp = *(const u32x4*)(pp + DFF), vc = *(const u32x4*)(pc + DFF), vn = *(const u32x4*)(pn + DFF);
        if (zp) { gp = z4; vp = z4; } if (zn) { gn = z4; vn = z4; }
        const unsigned gpw[4] = {gp.x, gp.y, gp.z, gp.w}, gcw[4] = {gc.x, gc.y, gc.z, gc.w}, gnw[4] = {gn.x, gn.y, gn.z, gn.w};
        const unsigned vpw[4] = {vp.x, vp.y, vp.z, vp.w}, vcw[4] = {vc.x, vc.y, vc.z, vc.w}, vnw[4] = {vn.x, vn.y, vn.z, vn.w};
        float tg[3][8], tv[3][8], tb[2][8];
#pragma unroll
        for (int k3 = 0; k3 < 3; ++k3)
#pragma unroll
            for (int hq = 0; hq < 2; ++hq) { const f32x4 x = *(const f32x4*)(a.conv_w + (size_t)k3 * UPC + ch + 4 * hq), y = *(const f32x4*)(a.conv_w + (size_t)k3 * UPC + DFF + ch + 4 * hq);
#pragma unroll
                for (int e = 0; e < 4; ++e) { tg[k3][4 * hq + e] = x[e]; tv[k3][4 * hq + e] = y[e]; } }
#pragma unroll
        for (int hq = 0; hq < 2; ++hq) { const f32x4 x = *(const f32x4*)(a.conv_b + ch + 4 * hq), y = *(const f32x4*)(a.conv_b + DFF + ch + 4 * hq);
#pragma unroll
            for (int e = 0; e < 4; ++e) { tb[0][4 * hq + e] = x[e]; tb[1][4 * hq + e] = y[e]; } }
        unsigned ow[4];
#pragma unroll
        for (int q = 0; q < 4; ++q) {
            const int e0 = 2 * q, e1 = e0 + 1;
            const float g0 = tg[0][e0] * bf_lo(gpw[q]) + tg[1][e0] * bf_lo(gcw[q]) + tg[2][e0] * bf_lo(gnw[q]) + tb[0][e0];
            const float g1 = tg[0][e1] * bf_hi(gpw[q]) + tg[1][e1] * bf_hi(gcw[q]) + tg[2][e1] * bf_hi(gnw[q]) + tb[0][e1];
            const float x0 = tv[0][e0] * bf_lo(vpw[q]) + tv[1][e0] * bf_lo(vcw[q]) + tv[2][e0] * bf_lo(vnw[q]) + tb[1][e0];
            const float x1 = tv[0][e1] * bf_hi(vpw[q]) + tv[1][e1] * bf_hi(vcw[q]) + tv[2][e1] * bf_hi(vnw[q]) + tb[1][e1];
            ow[q] = cvt_pk_bf16(gelu_tanh(g0) * x0, gelu_tanh(g1) * x1);
        }
        u32x4 o; o.x = ow[0]; o.y = ow[1]; o.z = ow[2]; o.w = ow[3];
        *(u32x4*)(U + (size_t)r * DFF + ch) = o;
    } }
    GRID_SYNC();
#if defined(DBG_STOP)
    if (DBG_STOP == 7) { dbg_dump(a, 7); return; }
#endif

    if (PH(8)) { PHASE_VIEW()
        pg8::Gemm gm{U, WdownT, DFF, DFF, DFF, 256, 0}; pg8::StaticOrder S; S.init(M, DM, G, bx);
        pg8::EpiF32 E{Y, DM}; pg8::gemm_phase(lds, gm, S, E, wave0);
    }
    GRID_SYNC();
#if defined(DBG_STOP)
    if (DBG_STOP == 8) { dbg_dump(a, 8); return; }
#endif

    if (PH(9)) { PHASE_VIEW()
    for (int m = gw; m < M; m += NGW) {
        const float* yr = Y + (size_t)m * DM; float* o = a.out + (size_t)m * DM;
        f32x4 v[8]; float s = 0.f;
#pragma unroll
        for (int j = 0; j < 8; ++j) { v[j] = __builtin_nontemporal_load((const f32x4*)(yr + 256 * j + 4 * lane)); s += (v[j][0] * v[j][0] + v[j][1] * v[j][1]) + (v[j][2] * v[j][2] + v[j][3] * v[j][3]); }
        const float rs = 1.0f / sqrtf(wave_sum(s) * (1.0f / DM) + NORM_EPS);
#pragma unroll
        for (int j = 0; j < 8; ++j) { const f32x4 gg = *(const f32x4*)(a.g_post_ffn + 256 * j + 4 * lane), xx = *(const f32x4*)(o + 256 * j + 4 * lane);
            *(f32x4*)(o + 256 * j + 4 * lane) = xx + v[j] * rs * gg; }
    } }
}

extern "C" void kernel_launch(void* const* d_in, const int* in_sizes, int n_in, void* d_out, int out_size, void* d_ws, size_t ws_size, hipStream_t stream) {
    static int grid = 0;
    if (grid == 0) {
        if (n_in != 21 || in_sizes[0] != M * DM || out_size != M * DM || ws_size < WS_NEED) { fprintf(stderr, "kernel_launch: unexpected shapes / workspace (n_in %d, ws %zu)\n", n_in, ws_size); grid = -1; return; }
        int dev = 0, cus = 0, per_cu = 0;
        (void)hipGetDevice(&dev);
        (void)hipDeviceGetAttribute(&cus, hipDeviceAttributeMultiprocessorCount, dev);
        if (hipFuncSetAttribute((const void*)fwd_kernel, hipFuncAttributeMaxDynamicSharedMemorySize, LDS_BYTES) != hipSuccess) { fprintf(stderr, "kernel_launch: hipFuncSetAttribute failed\n"); grid = -1; return; }
        (void)hipOccupancyMaxActiveBlocksPerMultiprocessor(&per_cu, (const void*)fwd_kernel, NTHR, LDS_BYTES);
        (void)hipGetLastError();
        if (per_cu < 1) per_cu = 1;
        grid = cus;
    }
    if (grid < 0) return;
    Args a{};
    a.x = (const float*)d_in[0]; a.g_pre_mix = (const float*)d_in[1]; a.w_in = (const float*)d_in[2]; a.b_gate = (const float*)d_in[3];
    a.lq1 = (const float*)d_in[4]; a.lk1 = (const float*)d_in[5]; a.lq2 = (const float*)d_in[6]; a.lk2 = (const float*)d_in[7]; a.subln = (const float*)d_in[8];
    a.w_attn = (const float*)d_in[9]; a.pool_w = (const float*)d_in[10]; a.pool_scale = (const float*)d_in[11]; a.w_poolb = (const float*)d_in[12]; a.w_out = (const float*)d_in[13];
    a.g_post_mix = (const float*)d_in[14]; a.g_pre_ffn = (const float*)d_in[15]; a.w_up = (const float*)d_in[16]; a.conv_w = (const float*)d_in[17]; a.conv_b = (const float*)d_in[18];
    a.w_down = (const float*)d_in[19]; a.g_post_ffn = (const float*)d_in[20];
    a.out = (float*)d_out; a.ws = (unsigned char*)d_ws;
    if (hipMemsetAsync((char*)d_ws + WS_CTL, 0, 16384, stream) != hipSuccess) { fprintf(stderr, "kernel_launch: memset of the barrier words failed\n"); return; }
    void* args[] = {&a};
    hipError_t e = hipLaunchCooperativeKernel((const void*)fwd_kernel, dim3(grid), dim3(NTHR), args, LDS_BYTES, stream);
    if (e != hipSuccess) fprintf(stderr, "cooperative launch failed: %s (grid %d)\n", hipGetErrorString(e), grid);
}
```

```cpp
#include <hip/hip_runtime.h>
#include <hip/hip_cooperative_groups.h>
#include <cstdio>
#include <cstdint>
namespace cg = cooperative_groups;

#define LAS __attribute__((address_space(3)))
typedef unsigned short bf16_t;
typedef short bf16x8 __attribute__((ext_vector_type(8)));
typedef float f32x4 __attribute__((ext_vector_type(4)));
typedef float f32x16 __attribute__((ext_vector_type(16)));
typedef unsigned u32x4 __attribute__((ext_vector_type(4)));
typedef unsigned u32x2 __attribute__((ext_vector_type(2)));

constexpr int NB = 4, SEQ = 4096, DM = 2048, M = NB * SEQ, NH = 8;
constexpr int INC = 8192, DFF = 5632, UPC = 2 * DFF;
constexpr float NORM_EPS = 1e-6f, SUBLN_EPS = 1e-5f, LAMBDA_INIT = 0.2f;
constexpr float LOG2E = 1.4426950408889634f;

constexpr size_t MiB = 1u << 20;
constexpr size_t WS_WDOWN = 0;
constexpr size_t WS_WIN = 22 * MiB;
constexpr size_t WS_WOUT = 54 * MiB;
constexpr size_t WS_WCAT = 62 * MiB;
constexpr size_t WS_WPT = 70 * MiB;
constexpr size_t WS_PWS = 74 * MiB;
constexpr size_t WS_H = 75 * MiB;
constexpr size_t WS_OPM = 75 * MiB;
constexpr size_t WS_QK = 139 * MiB;
constexpr size_t WS_MERGED = 139 * MiB;
constexpr size_t WS_VT = 203 * MiB;
constexpr size_t WS_PZ = 235 * MiB;
constexpr size_t WS_T = 203 * MiB;
constexpr size_t WS_GATES = 267 * MiB;
constexpr size_t WS_MO = 203 * MiB;
constexpr size_t WS_H2 = 385 * MiB;
constexpr size_t WS_WUP = 449 * MiB;
constexpr size_t WS_U = 22 * MiB;
constexpr size_t WS_SIDE = 198 * MiB;
constexpr size_t WS_Y = 374 * MiB;
constexpr size_t WS_CTL = 502 * MiB;
constexpr size_t WS_NEED = 503 * MiB;

typedef float f32x2_t __attribute__((ext_vector_type(2))); typedef __bf16 bf16x2_t __attribute__((ext_vector_type(2)));
__device__ __forceinline__ unsigned cvt_pk_bf16(float lo, float hi) { const f32x2_t v = {lo, hi}; const bf16x2_t b = __builtin_convertvector(v, bf16x2_t); return __builtin_bit_cast(unsigned, b); }
__device__ __forceinline__ float bf_lo(unsigned w) { return __uint_as_float(w << 16); }
__device__ __forceinline__ float bf_hi(unsigned w) { return __uint_as_float(w & 0xffff0000u); }
__device__ __forceinline__ float sigmoidf_(float x) { return __builtin_amdgcn_rcpf(1.0f + __builtin_amdgcn_exp2f(-x * LOG2E)); }
__device__ __forceinline__ float gelu_tanh(float x) { const float z = 0.7978845608028654f * (x + 0.044715f * x * x * x); return x * __builtin_amdgcn_rcpf(1.0f + __builtin_amdgcn_exp2f(-2.0f * LOG2E * z)); }

__device__ __forceinline__ int lane_id_volatile() { int l; asm volatile("v_mbcnt_lo_u32_b32 %0, -1, 0\n\tv_mbcnt_hi_u32_b32 %0, -1, %0" : "=v"(l)); return l; }
#define MY_TID(w0) (((w0) << 6) | lane_id_volatile())
namespace pg8 {
constexpr int BM = 256, BK = 64, HALF = 128, HTB = HALF * BK * 2, STAGE_BYTES = 8 * HTB, NXCD = 8, WGM = 8;
__host__ __device__ __forceinline__ int lds_byte(int r, int c) { const int st = (r >> 4) * 2 + (c >> 5), rr = r & 15, cc = c & 31, ob = rr * 64 + cc * 2; return st * 1024 + (ob ^ (((ob >> 9) & 1) << 5)); }
__host__ __device__ __forceinline__ void stage_rc(int b, int& R, int& C) { const int st = b / 1024, sb = b % 1024, swz = sb ^ (((sb >> 9) & 1) << 5); R = (st >> 1) * 16 + swz / 64; C = (st & 1) * 32 + (swz % 64) / 2; }
__host__ __device__ __forceinline__ int perm32(int rho) { const int n = rho >> 4, i = rho & 15; return 8 * (i >> 2) + 4 * n + (i & 3); }

struct Unit { int pm, pn; };
struct Gemm { const bf16_t* A; const bf16_t* Bt; int lda, ldb, K, ak2, apn; };

struct StaticOrder {
    int nM, nN, nwg, G, c;
    __device__ void init(int M_, int N_, int G_, int c_) { nM = M_ / BM; nN = N_ / BM; nwg = nM * nN; G = G_; c = c_; }
    __device__ bool next(int i, Unit& u) const {
        const long L = (long)i * G + c; if (L >= nwg) return false;
        int wgid = (int)L; { const int q = nwg / NXCD, r = nwg % NXCD, xcd = wgid % NXCD, off = wgid / NXCD; wgid = (xcd < r ? xcd * (q + 1) : r * (q + 1) + (xcd - r) * q) + off; }
        const int nig = WGM * nN, gid = wgid / nig, fm = gid * WGM, gsz = (nM - fm) < WGM ? (nM - fm) : WGM;
        u.pm = fm + ((wgid % nig) % gsz); u.pn = (wgid % nig) / gsz; return true;
    }
};

typedef f32x4 Acc[2][2][4][2];

template <class Epi>
__device__ __forceinline__ void gemm_phase(LAS unsigned char* lds, const Gemm g, const StaticOrder& S, const Epi& E, int wave0) {
    int tid_ = MY_TID(wave0); asm volatile("" : "+v"(tid_));
    const int tid = tid_, wid = __builtin_amdgcn_readfirstlane(tid >> 6), lane = tid & 63, wr = wid >> 2, wc = wid & 3, fr = lane & 15, fq = lane >> 4;
    const int K = g.K, nt = K / BK;
    unsigned voffA[2], voffB[2];
#pragma unroll
    for (int i = 0; i < 2; ++i) { int R, C; stage_rc(tid * 16 + i * 8192, R, C); const int Rb = Epi::PERM ? ((R & ~31) + perm32(R & 31)) : R;
        voffA[i] = (unsigned)(R * g.lda + C) * 2u; voffB[i] = (unsigned)(Rb * g.ldb + C) * 2u; }
    const size_t kstep = (size_t)(BK * 2);
    const size_t ak2 = (size_t)g.ak2;
    const size_t hstepA = (size_t)HALF * g.lda * 2, hstepB = (size_t)HALF * g.ldb * 2;
    const size_t tstepA = 2 * hstepA, tstepB = 2 * hstepB;
    const unsigned ldsw = (unsigned)wid * 1024u;
    const int aoff = lds_byte(wr * 64 + fr, fq * 8), boff = lds_byte(wc * 32 + fr, fq * 8);
#define PG8_SA(b, h) (((b) * 2 + (h)) * HTB)
#define PG8_SB(b, h) ((4 + (b) * 2 + (h)) * HTB)
#define PG8_STAGE(bufoff, gbase, voff) do { _Pragma("unroll") for (int _i = 0; _i < 2; ++_i) \
        __builtin_amdgcn_global_load_lds((const unsigned*)((const char*)(gbase) + (voff)[_i]), (LAS unsigned*)(lds + (bufoff) + ldsw + _i * 8192), 16, 0, 0); } while (0)
#define PG8_LDA(dst, b, h) do { _Pragma("unroll") for (int m = 0; m < 4; ++m) _Pragma("unroll") for (int k = 0; k < 2; ++k) dst[m][k] = *(const LAS bf16x8*)(lds + PG8_SA(b, h) + aoff + m * 2048 + k * 1024); } while (0)
#define PG8_LDB(dst, b, h) do { _Pragma("unroll") for (int n = 0; n < 2; ++n) _Pragma("unroll") for (int k = 0; k < 2; ++k) dst[n][k] = *(const LAS bf16x8*)(lds + PG8_SB(b, h) + boff + n * 2048 + k * 1024); } while (0)
#define PG8_MMA(ai, bj, At, Bt) do { __builtin_amdgcn_s_setprio(1); _Pragma("unroll") for (int m = 0; m < 4; ++m) _Pragma("unroll") for (int n = 0; n < 2; ++n) _Pragma("unroll") for (int k = 0; k < 2; ++k) \
        acc[ai][bj][m][n] = __builtin_amdgcn_mfma_f32_16x16x32_bf16(Bt[n][k], At[m][k], acc[ai][bj][m][n], 0, 0, 0); __builtin_amdgcn_s_setprio(0); } while (0)
#define PG8_WAIT_V(n) asm volatile("s_waitcnt vmcnt(" #n ")" ::: "memory")
#define PG8_WAIT_L(n) asm volatile("s_waitcnt lgkmcnt(" #n ")" ::: "memory")
#define PG8_BAR __builtin_amdgcn_s_barrier()
#define PG8_SCHED __builtin_amdgcn_sched_barrier(0)
    Unit cur, nxt; int ui = 0;
    if (!S.next(0, cur)) return;
    Acc acc;
#pragma unroll
    for (int a = 0; a < 2; ++a)
#pragma unroll
        for (int b = 0; b < 2; ++b)
#pragma unroll
            for (int m = 0; m < 4; ++m)
#pragma unroll
                for (int n = 0; n < 2; ++n) acc[a][b][m][n] = (f32x4){0.f, 0.f, 0.f, 0.f};
    bf16x8 At[4][2], B0[2][2], B1[2][2];
    const char* cA = (const char*)g.A + (size_t)cur.pm * tstepA + (size_t)cur.pn * g.apn; const char* cB = (const char*)g.Bt + (size_t)cur.pn * tstepB;
    PG8_STAGE(PG8_SB(0, 0), cB, voffB); PG8_STAGE(PG8_SB(0, 1), cB + hstepB, voffB); PG8_STAGE(PG8_SA(0, 0), cA, voffA); PG8_STAGE(PG8_SA(0, 1), cA + hstepA, voffA);
    if (wr == 1) PG8_BAR;
    PG8_WAIT_V(2); PG8_BAR;
    PG8_STAGE(PG8_SB(1, 0), cB + kstep, voffB); PG8_STAGE(PG8_SA(1, 0), cA + kstep, voffA); PG8_STAGE(PG8_SB(1, 1), cB + hstepB + kstep, voffB);
    PG8_WAIT_V(6); PG8_BAR;
    for (;;) {
        const bool has_next = S.next(ui + 1, nxt);
        const char* nA = has_next ? (const char*)g.A + (size_t)nxt.pm * tstepA + (size_t)nxt.pn * g.apn : cA; const char* nB = has_next ? (const char*)g.Bt + (size_t)nxt.pn * tstepB : cB;
        const int nhalf_ = Epi::MID ? 2 : 1, tspan_ = nt / nhalf_;
#pragma unroll 1
        for (int hk = 0; hk < nhalf_; ++hk) {
        if constexpr (Epi::MID) { if (hk == 1) E.mid(acc, cur, wr, wc, fr, fq); }
#pragma unroll 1
        for (int t = hk * tspan_; t < (hk + 1) * tspan_; t += 2) {
            const bool last = (t == nt - 2);
            const char* aT = cA + (size_t)(t >> 1) * ak2;
            const char* a1 = aT + kstep;
            const char* a2 = last ? nA : aT + ak2; const char* b2 = last ? nB : cB + (size_t)(t + 2) * kstep;
            const char* a3 = a2 + kstep; const char* b3 = b2 + kstep;
            PG8_LDB(B0, 0, 0); PG8_LDB(B1, 0, 1); PG8_SCHED; PG8_LDA(At, 0, 0); PG8_STAGE(PG8_SA(1, 1), a1 + hstepA, voffA);
            PG8_WAIT_V(8); PG8_WAIT_L(0); PG8_BAR; PG8_MMA(0, 0, At, B0); PG8_MMA(0, 1, At, B1); PG8_BAR; PG8_SCHED;
            PG8_LDA(At, 0, 1); PG8_STAGE(PG8_SB(0, 0), b2, voffB); PG8_STAGE(PG8_SB(0, 1), b2 + hstepB, voffB); PG8_STAGE(PG8_SA(0, 0), a2, voffA);
            PG8_WAIT_V(8); PG8_WAIT_L(0); PG8_BAR; PG8_MMA(1, 0, At, B0); PG8_MMA(1, 1, At, B1); PG8_BAR; PG8_SCHED;
            PG8_LDB(B0, 1, 0); PG8_LDB(B1, 1, 1); PG8_SCHED; PG8_LDA(At, 1, 0); PG8_STAGE(PG8_SA(0, 1), a2 + hstepA, voffA);
            PG8_WAIT_V(8); PG8_WAIT_L(0); PG8_BAR; PG8_MMA(0, 0, At, B0); PG8_MMA(0, 1, At, B1); PG8_BAR; PG8_SCHED;
            PG8_LDA(At, 1, 1); PG8_STAGE(PG8_SB(1, 0), b3, voffB); PG8_STAGE(PG8_SB(1, 1), b3 + hstepB, voffB); PG8_STAGE(PG8_SA(1, 0), a3, voffA);
            PG8_WAIT_V(8); PG8_WAIT_L(0); PG8_BAR; PG8_MMA(1, 0, At, B0); PG8_MMA(1, 1, At, B1); PG8_BAR; PG8_SCHED;
        }
        }
        if (wr == 0) PG8_BAR;
        E(acc, cur, wr, wc, fr, fq);
        if (!has_next) break;
#pragma unroll
        for (int a = 0; a < 2; ++a)
#pragma unroll
            for (int b = 0; b < 2; ++b)
#pragma unroll
                for (int m = 0; m < 4; ++m)
#pragma unroll
                    for (int n = 0; n < 2; ++n) acc[a][b][m][n] = (f32x4){0.f, 0.f, 0.f, 0.f};
        cur = nxt; cA = nA; cB = nB; ++ui;
        if (wr == 1) PG8_BAR;
    }
    PG8_WAIT_V(0);
    PG8_BAR;
#undef PG8_SA
#undef PG8_SB
#undef PG8_STAGE
#undef PG8_LDA
#undef PG8_LDB
#undef PG8_MMA
#undef PG8_WAIT_V
#undef PG8_WAIT_L
#undef PG8_BAR
#undef PG8_SCHED
}

__device__ __forceinline__ u32x4 pack8(f32x4 v0, f32x4 v1) { u32x4 w; w.x = cvt_pk_bf16(v0[0], v0[1]); w.y = cvt_pk_bf16(v0[2], v0[3]); w.z = cvt_pk_bf16(v1[0], v1[1]); w.w = cvt_pk_bf16(v1[2], v1[3]); return w; }

template <bool SIDE> struct EpiBf16 {
    static constexpr bool PERM = true; static constexpr bool MID = false;
    bf16_t* O; int ldc; bf16_t* side;
    __device__ __forceinline__ void operator()(const Acc& acc, const Unit& u, int wr, int wc, int fr, int fq) const {
        const int row0 = u.pm * BM + wr * 64 + fr, col0 = u.pn * BM + wc * 32 + 8 * fq;
#pragma unroll
        for (int ai = 0; ai < 2; ++ai)
#pragma unroll
            for (int m = 0; m < 4; ++m) { const int row = row0 + ai * HALF + m * 16; bf16_t* rowp = O + (size_t)row * ldc + col0;
#pragma unroll
                for (int bj = 0; bj < 2; ++bj) { const u32x4 w = pack8(acc[ai][bj][m][0], acc[ai][bj][m][1]); *(u32x4*)(rowp + bj * HALF) = w;
                    if (SIDE && bj == 0) { const bool top = (fr == 0) && ((m & 1) == 0), bot = (fr == 15) && ((m & 1) == 1);
                        if (top || bot) *(u32x4*)(side + (size_t)((row >> 5) * 2 + (bot ? 1 : 0)) * DFF + u.pn * HALF + wc * 32 + 8 * fq) = w; } } }
    }
};
struct EpiF32 {
    static constexpr bool PERM = false; static constexpr bool MID = false;
    float* O; int ldc;
    __device__ __forceinline__ void operator()(const Acc& acc, const Unit& u, int wr, int wc, int fr, int fq) const {
        const int row0 = u.pm * BM + wr * 64 + fr, col0 = u.pn * BM + wc * 32 + 4 * fq;
#pragma unroll
        for (int ai = 0; ai < 2; ++ai)
#pragma unroll
            for (int m = 0; m < 4; ++m) { float* rowp = O + (size_t)(row0 + ai * HALF + m * 16) * ldc + col0;
#pragma unroll
                for (int bj = 0; bj < 2; ++bj)
#pragma unroll
                    for (int n = 0; n < 2; ++n) *(f32x4*)(rowp + bj * HALF + n * 16) = acc[ai][bj][m][n]; }
    }
};
template <int MODE> struct EpiGate {
    static constexpr bool PERM = true; static constexpr bool MID = false;
    const bf16_t* gates; bf16_t* T; bf16_t* OUT;
    __device__ __forceinline__ void operator()(const Acc& acc, const Unit& u, int wr, int wc, int fr, int fq) const {
        const int row0 = u.pm * BM + wr * 64 + fr, col0 = u.pn * BM + wc * 32 + 8 * fq;
#pragma unroll
        for (int ai = 0; ai < 2; ++ai)
#pragma unroll
            for (int m = 0; m < 4; ++m) { const size_t row = (size_t)(row0 + ai * HALF + m * 16);
#pragma unroll
                for (int bj = 0; bj < 2; ++bj) { const int col = col0 + bj * HALF;
                    const u32x4 gw = *(const u32x4*)(gates + row * 4096 + MODE * 2048 + col);
                    f32x4 v0 = acc[ai][bj][m][0], v1 = acc[ai][bj][m][1];
                    v0[0] *= bf_lo(gw.x); v0[1] *= bf_hi(gw.x); v0[2] *= bf_lo(gw.y); v0[3] *= bf_hi(gw.y);
                    v1[0] *= bf_lo(gw.z); v1[1] *= bf_hi(gw.z); v1[2] *= bf_lo(gw.w); v1[3] *= bf_hi(gw.w);
                    if (MODE == 1) { const u32x4 tw = *(const u32x4*)(T + row * DM + col);
                        v0[0] += bf_lo(tw.x); v0[1] += bf_hi(tw.x); v0[2] += bf_lo(tw.y); v0[3] += bf_hi(tw.y);
                        v1[0] += bf_lo(tw.z); v1[1] += bf_hi(tw.z); v1[2] += bf_lo(tw.w); v1[3] += bf_hi(tw.w);
                        *(u32x4*)(OUT + row * DM + col) = pack8(v0, v1);
                    } else *(u32x4*)(T + row * DM + col) = pack8(v0, v1); }
                asm volatile("" ::: "memory"); }
    }
};
struct EpiConv {
    static constexpr bool PERM = true; static constexpr bool MID = false;
    bf16_t* A; bf16_t* side; const float* cw; const float* cb; LAS unsigned char* scr;
    static __device__ __forceinline__ float ror1(float v) { return __int_as_float(__builtin_amdgcn_update_dpp(0, __float_as_int(v), 0x121, 0xF, 0xF, true)); }
    static __device__ __forceinline__ float ror15(float v) { return __int_as_float(__builtin_amdgcn_update_dpp(0, __float_as_int(v), 0x12F, 0xF, 0xF, true)); }
    static __device__ __forceinline__ float shr1_keep(float old, float v) { return __int_as_float(__builtin_amdgcn_update_dpp(__float_as_int(old), __float_as_int(v), 0x111, 0xF, 0xF, false)); }
    static __device__ __forceinline__ float shl1_keep(float old, float v) { return __int_as_float(__builtin_amdgcn_update_dpp(__float_as_int(old), __float_as_int(v), 0x101, 0xF, 0xF, false)); }
    __device__ __forceinline__ void operator()(const Acc& acc, const Unit& u, int wr, int wc, int fr_in, int fq_in) const {
        (void)fr_in; (void)fq_in; const int l_ = lane_id_volatile(); const int fr = l_ & 15, fq = l_ >> 4;
        int ch0 = u.pn * HALF + wc * 32 + 8 * fq, row0 = u.pm * BM + wr * 64 + fr;
        asm volatile("" : "+v"(ch0), "+v"(row0));
        const bool f0 = (fr == 0), f15 = (fr == 15);
#pragma unroll
        for (int n = 0; n < 2; ++n) {
            const int ch = ch0 + 4 * n;
            const f32x4 tg0 = *(const f32x4*)(cw + ch), tg1 = *(const f32x4*)(cw + UPC + ch), tg2 = *(const f32x4*)(cw + 2 * UPC + ch), tbg = *(const f32x4*)(cb + ch);
            const f32x4 tv0 = *(const f32x4*)(cw + DFF + ch), tv1 = *(const f32x4*)(cw + UPC + DFF + ch), tv2 = *(const f32x4*)(cw + 2 * UPC + DFF + ch), tbv = *(const f32x4*)(cb + DFF + ch);
#pragma unroll
            for (int ai = 0; ai < 2; ++ai) {
                LAS unsigned* mys = (LAS unsigned*)(scr + (wr * 4 + wc) * 2048 + l_ * 32);
#pragma unroll
                for (int j = 0; j < 4; ++j) {
                    const float wg0 = tg0[j], wg1 = tg1[j], wg2 = tg2[j], bg = tbg[j];
                    const float wv0 = tv0[j], wv1 = tv1[j], wv2 = tv2[j], bv = tbv[j];
                    float keep[4];
                    { float p1[4], p5[4];
#pragma unroll
                      for (int m = 0; m < 4; ++m) { p1[m] = ror1(acc[ai][0][m][n][j]); p5[m] = ror15(acc[ai][0][m][n][j]); }
#pragma unroll
                      for (int m = 0; m < 4; ++m) { const int mp = m > 0 ? m - 1 : 0, mn = m < 3 ? m + 1 : 3;
                          keep[m] = wg0 * (f0 ? p1[mp] : p1[m]) + wg1 * acc[ai][0][m][n][j] + wg2 * (f15 ? p5[mn] : p5[m]) + bg; } }
                    __builtin_amdgcn_sched_barrier(0);
                    { float p1[4], p5[4];
#pragma unroll
                      for (int m = 0; m < 4; ++m) { p1[m] = ror1(acc[ai][1][m][n][j]); p5[m] = ror15(acc[ai][1][m][n][j]); }
#pragma unroll
                      for (int m = 0; m < 4; ++m) { const int mp = m > 0 ? m - 1 : 0, mn = m < 3 ? m + 1 : 3;
                          const float v = wv0 * (f0 ? p1[mp] : p1[m]) + wv1 * acc[ai][1][m][n][j] + wv2 * (f15 ? p5[mn] : p5[m]) + bv;
                          keep[m] = gelu_tanh(keep[m]) * v; } }
                    __builtin_amdgcn_sched_barrier(0);
#pragma unroll
                    for (int m = 0; m < 4; ++m) *(LAS bf16_t*)((LAS unsigned char*)mys + m * 8 + j * 2) = (bf16_t)(cvt_pk_bf16(keep[m], 0.f) & 0xffffu);
                    __builtin_amdgcn_sched_barrier(0);
                }
#pragma unroll
                for (int m = 0; m < 4; ++m) { const int row = row0 + ai * HALF + m * 16;
                    const bool edge = (m == 0 && f0) || (m == 3 && f15);
                    const u32x2 w = *(const LAS u32x2*)(mys + m * 2);
                    if (!edge) *(u32x2*)(A + (size_t)row * DFF + ch) = w;
                    const int idx = (m == 0) ? fr : fr - 12;
                    if ((m == 0 && fr < 2) || (m == 3 && fr >= 14)) { bf16_t* sp = side + ((size_t)(row >> 6) * 4 + idx) * UPC + ch;
                        u32x2 rg, rv; rg.x = cvt_pk_bf16(acc[ai][0][m][n][0], acc[ai][0][m][n][1]); rg.y = cvt_pk_bf16(acc[ai][0][m][n][2], acc[ai][0][m][n][3]);
                        rv.x = cvt_pk_bf16(acc[ai][1][m][n][0], acc[ai][1][m][n][1]); rv.y = cvt_pk_bf16(acc[ai][1][m][n][2], acc[ai][1][m][n][3]);
                        *(u32x2*)sp = rg; *(u32x2*)(sp + DFF) = rv; } }
                asm volatile("" ::: "memory"); __builtin_amdgcn_sched_barrier(0);
            }
        }
    }
};
struct EpiGateMid {
    static constexpr bool PERM = true; static constexpr bool MID = true;
    const bf16_t* gates; bf16_t* OUT;
    __device__ __forceinline__ void mid(Acc& acc, const Unit& u, int wr, int wc, int fr, int fq) const {
        int row0 = u.pm * BM + wr * 64 + fr, col0 = u.pn * BM + wc * 32 + 8 * fq;
        asm volatile("" : "+v"(row0), "+v"(col0));
#pragma unroll
        for (int ai = 0; ai < 2; ++ai) {
#pragma unroll
            for (int m = 0; m < 4; ++m) { const size_t row = (size_t)(row0 + ai * HALF + m * 16);
#pragma unroll
                for (int bj = 0; bj < 2; ++bj) { const int col = col0 + bj * HALF;
                    const u32x4 g0 = *(const u32x4*)(gates + row * 4096 + col), g1 = *(const u32x4*)(gates + row * 4096 + 2048 + col);
                    const unsigned a0[4] = {g0.x, g0.y, g0.z, g0.w}, a1[4] = {g1.x, g1.y, g1.z, g1.w};
#pragma unroll
                    for (int q = 0; q < 4; ++q) { const float r0 = bf_lo(a0[q]) * __builtin_amdgcn_rcpf(fmaxf(bf_lo(a1[q]), 1e-6f)), r1 = bf_hi(a0[q]) * __builtin_amdgcn_rcpf(fmaxf(bf_hi(a1[q]), 1e-6f));
                        acc[ai][bj][m][q >> 1][2 * (q & 1)] *= r0; acc[ai][bj][m][q >> 1][2 * (q & 1) + 1] *= r1; } }
                if (m & 1) { asm volatile("" ::: "memory"); __builtin_amdgcn_sched_barrier(0); } } }
    }
    __device__ __forceinline__ void operator()(const Acc& acc, const Unit& u, int wr, int wc, int fr, int fq) const {
        const int row0 = u.pm * BM + wr * 64 + fr, col0 = u.pn * BM + wc * 32 + 8 * fq;
#pragma unroll
        for (int ai = 0; ai < 2; ++ai)
#pragma unroll
            for (int m = 0; m < 4; ++m) { const size_t row = (size_t)(row0 + ai * HALF + m * 16);
#pragma unroll
                for (int bj = 0; bj < 2; ++bj) { const int col = col0 + bj * HALF;
                    const u32x4 gw = *(const u32x4*)(gates + row * 4096 + 2048 + col);
                    f32x4 v0 = acc[ai][bj][m][0], v1 = acc[ai][bj][m][1];
                    v0[0] *= fmaxf(bf_lo(gw.x), 1e-6f); v0[1] *= fmaxf(bf_hi(gw.x), 1e-6f); v0[2] *= fmaxf(bf_lo(gw.y), 1e-6f); v0[3] *= fmaxf(bf_hi(gw.y), 1e-6f);
                    v1[0] *= fmaxf(bf_lo(gw.z), 1e-6f); v1[1] *= fmaxf(bf_hi(gw.z), 1e-6f); v1[2] *= fmaxf(bf_lo(gw.w), 1e-6f); v1[3] *= fmaxf(bf_hi(gw.w), 1e-6f);
                    *(u32x4*)(OUT + row * DM + col) = pack8(v0, v1); }
                asm volatile("" ::: "memory"); }
    }
};
struct EpiZ {
    static constexpr bool PERM = true; static constexpr bool MID = false;
    bf16_t* qk; bf16_t* vt; bf16_t* pz; bf16_t* gates; const float* bgate; float qscale;
    __device__ __forceinline__ void operator()(const Acc& acc, const Unit& u, int wr, int wc, int fr, int fq) const {
        const int row0 = u.pm * BM + wr * 64 + fr, cl = wc * 32 + 8 * fq;
        if (u.pn < 8) {
            const float sc = (u.pn < 4) ? qscale : 1.0f;
#pragma unroll
            for (int ai = 0; ai < 2; ++ai)
#pragma unroll
                for (int m = 0; m < 4; ++m) { bf16_t* rowp = qk + (size_t)(row0 + ai * HALF + m * 16) * 2048 + u.pn * BM + cl;
#pragma unroll
                    for (int bj = 0; bj < 2; ++bj) *(u32x4*)(rowp + bj * HALF) = pack8(acc[ai][bj][m][0] * sc, acc[ai][bj][m][1] * sc); }
        } else if (u.pn < 12) {
            const int b = u.pm >> 4, s0 = (u.pm & 15) * BM + wr * 64 + fr;
#pragma unroll
            for (int bj = 0; bj < 2; ++bj) { const int h = 2 * (u.pn - 8) + bj;
#pragma unroll
                for (int n = 0; n < 2; ++n)
#pragma unroll
                    for (int j = 0; j < 4; ++j) { bf16_t* base = vt + ((size_t)((b * NH + h) * 128 + cl + 4 * n + j)) * SEQ + s0;
#pragma unroll
                        for (int ai = 0; ai < 2; ++ai)
#pragma unroll
                            for (int m = 0; m < 4; ++m) base[ai * HALF + m * 16] = (bf16_t)(cvt_pk_bf16(acc[ai][bj][m][n][j], 0.f) & 0xffffu);
                        asm volatile("" ::: "memory"); } }
        } else if (u.pn < 16) {
#pragma unroll
            for (int ai = 0; ai < 2; ++ai)
#pragma unroll
                for (int m = 0; m < 4; ++m) { bf16_t* rowp = pz + (size_t)(row0 + ai * HALF + m * 16) * 1024 + (u.pn - 12) * BM + cl;
#pragma unroll
                    for (int bj = 0; bj < 2; ++bj) *(u32x4*)(rowp + bj * HALF) = pack8(acc[ai][bj][m][0], acc[ai][bj][m][1]); }
        } else {
            const int gc = (u.pn - 16) * BM + cl;
#pragma unroll
            for (int bj = 0; bj < 2; ++bj) {
                const f32x4 b0 = *(const f32x4*)(bgate + gc + bj * HALF), b1 = *(const f32x4*)(bgate + gc + bj * HALF + 4);
#pragma unroll
                for (int ai = 0; ai < 2; ++ai)
#pragma unroll
                    for (int m = 0; m < 4; ++m) { bf16_t* rowp = gates + (size_t)(row0 + ai * HALF + m * 16) * 4096 + gc + bj * HALF;
                        f32x4 v0 = acc[ai][bj][m][0] + b0, v1 = acc[ai][bj][m][1] + b1;
#pragma unroll
                        for (int j = 0; j < 4; ++j) { v0[j] = sigmoidf_(v0[j]); v1[j] = sigmoidf_(v1[j]); }
                        *(u32x4*)rowp = pack8(v0, v1);
                        asm volatile("" ::: "memory"); __builtin_amdgcn_sched_barrier(0); } }
        }
    }
};
}

struct Args {
    const float* x; const float* g_pre_mix; const float* w_in; const float* b_gate;
    const float* lq1; const float* lk1; const float* lq2; const float* lk2; const float* subln;
    const float* w_attn; const float* pool_w; const float* pool_scale; const float* w_poolb; const float* w_out;
    const float* g_post_mix; const float* g_pre_ffn; const float* w_up; const float* conv_w; const float* conv_b;
    const float* w_down; const float* g_post_ffn;
    float* out; unsigned char* ws;
};

#ifndef PH_MASK
#define PH_MASK 0x3ff
#endif
#define PH(k) ((PH_MASK >> (k)) & 1)
constexpr int NTHR = 512, NWAVES = 8;
constexpr int LDS_BYTES = 147456 + 256;

__device__ __forceinline__ float wave_sum(float v) {
    const int l = lane_id_volatile();
#pragma unroll
    for (int o = 1; o < 64; o <<= 1) v += __int_as_float(__builtin_amdgcn_ds_bpermute((l ^ o) << 2, __float_as_int(v)));
    return v;
}

template <int MAP>
__device__ __forceinline__ void transpose_item(const float* W, int K, int N, bf16_t* WT, int ldd, LAS float* scr, int item, int lane) {
    const int nblk = N / 32, kb = item / nblk, nb = item % nblk, k0 = 64 * kb, n0 = 32 * nb;
#pragma unroll 8
    for (int i = 0; i < 32; ++i) { const int kk = 2 * i + (lane >> 5); scr[kk * 33 + (lane & 31)] = __builtin_nontemporal_load(W + (size_t)(k0 + kk) * N + n0 + (lane & 31)); }
    asm volatile("s_waitcnt lgkmcnt(0)" ::: "memory");
    int d0 = n0;
    if (MAP == 1) { const int half = n0 >= DFF ? 1 : 0, j = n0 - half * DFF; d0 = 256 * (j >> 7) + 128 * half + (j & 127); }
    const int c = lane & 7;
#pragma unroll
    for (int j = 0; j < 4; ++j) { const int n = (lane >> 3) + 8 * j; const LAS float* s = scr + (8 * c) * 33 + n;
        u32x4 o; o.x = cvt_pk_bf16(s[0 * 33], s[1 * 33]); o.y = cvt_pk_bf16(s[2 * 33], s[3 * 33]); o.z = cvt_pk_bf16(s[4 * 33], s[5 * 33]); o.w = cvt_pk_bf16(s[6 * 33], s[7 * 33]);
        *(u32x4*)(WT + (size_t)(d0 + n) * ldd + k0 + 8 * c) = o; }
    asm volatile("s_waitcnt lgkmcnt(0)" ::: "memory");
}

__device__ __forceinline__ void rms_row_bf16(const float* xrow, const float* g, bf16_t* orow, int lane) {
    f32x4 v[8]; float s = 0.f;
#pragma unroll
    for (int j = 0; j < 8; ++j) { v[j] = __builtin_nontemporal_load((const f32x4*)(xrow + 256 * j + 4 * lane)); s += (v[j][0] * v[j][0] + v[j][1] * v[j][1]) + (v[j][2] * v[j][2] + v[j][3] * v[j][3]); }
    const float rs = 1.0f / sqrtf(wave_sum(s) * (1.0f / DM) + NORM_EPS);
#pragma unroll
    for (int j = 0; j < 8; ++j) { const f32x4 gg = *(const f32x4*)(g + 256 * j + 4 * lane); const f32x4 o = v[j] * rs * gg;
        u32x2 w; w.x = cvt_pk_bf16(o[0], o[1]); w.y = cvt_pk_bf16(o[2], o[3]); *(u32x2*)(orow + 256 * j + 4 * lane) = w; }
}

constexpr int KPITCH = 144;
constexpr int KS_BYTES = 64 * KPITCH, VS_BYTES = 128 * KPITCH, ABUF = KS_BYTES + VS_BYTES;

__device__ __forceinline__ float swap_max(float v) { auto rr = __builtin_amdgcn_permlane32_swap(__float_as_uint(v), __float_as_uint(v), false, false); return fmaxf(__uint_as_float(rr[0]), __uint_as_float(rr[1])); }
__device__ __forceinline__ float swap_sum(float v) { auto rr = __builtin_amdgcn_permlane32_swap(__float_as_uint(v), __float_as_uint(v), false, false); return __uint_as_float(rr[0]) + __uint_as_float(rr[1]); }

__device__ __forceinline__ void attn_unit(LAS unsigned char* lds, const bf16_t* __restrict__ qk, const bf16_t* __restrict__ vt, bf16_t* __restrict__ opm,
                                          const float* __restrict__ subln, int b, int h, int qb, float lam, float c2, int wave0) {
    int tid_ = MY_TID(wave0); asm volatile("" : "+v"(tid_));
    const int tid = tid_, lane = tid & 63, ql = lane & 31, hi = lane >> 5; const int wid = __builtin_amdgcn_readfirstlane(tid >> 6);
    const int qpos = qb * 256 + wid * 32 + ql;
    __attribute__((address_space(1))) const float* subln_ = (__attribute__((address_space(1))) const float*)subln; asm volatile("" : "+s"(subln_));
    const size_t rowbase = (size_t)b * SEQ;
    const int kr = tid >> 3, kc = tid & 7;
    const bf16_t* vsrc0 = vt + ((size_t)((b * NH + h) * 128 + (tid >> 3))) * SEQ + kc * 8;
    const bf16_t* vsrc1 = vsrc0 + (size_t)64 * SEQ;
    const int kdst = kr * KPITCH + kc * 16, vdst0 = KS_BYTES + (tid >> 3) * KPITCH + kc * 16, vdst1 = vdst0 + 64 * KPITCH;
    const int pirow = 16 * (ql >> 4) + 8 * ((ql >> 2) & 1) + 4 * ((ql >> 3) & 1) + (ql & 3);
    const int kfo = pirow * KPITCH + hi * 16;
    const int vfo = KS_BYTES + ql * KPITCH + hi * 16;
    constexpr int RV = 3 * KS_BYTES, RO = RV + 3 * VS_BYTES;
    const int vdstr0 = (tid >> 3) * KPITCH + kc * 16, vdstr1 = vdstr0 + 64 * KPITCH, vfr = ql * KPITCH + hi * 16;
    const int qoff = RO + wid * 4096 + lane * 16;
#pragma unroll 1
    for (int c = 0; c < 2; ++c) {
        const bf16_t* qrow = qk + (rowbase + qpos) * 2048 + h * 128 + c * 64 + hi * 8;
        bf16x8 qf[4];
#pragma unroll
        for (int dd = 0; dd < 4; ++dd) qf[dd] = *(const bf16x8*)(qrow + dd * 16);
        const bf16_t* ksrc = qk + (rowbase + kr) * 2048 + 1024 + h * 128 + c * 64 + kc * 8;
        f32x16 O[4];
#pragma unroll
        for (int db = 0; db < 4; ++db)
#pragma unroll
            for (int r = 0; r < 16; ++r) O[db][r] = 0.f;
        float mrun = -1e30f, lrun = 0.f;
#pragma unroll
        for (int dd = 0; dd < 4; ++dd) *(LAS bf16x8*)(lds + qoff + dd * 1024) = qf[dd];
        u32x4 kR, vR0, vR1;
        { const u32x4 k0_ = *(const u32x4*)ksrc, v0_ = *(const u32x4*)vsrc0, v1_ = *(const u32x4*)vsrc1;
          *(LAS u32x4*)(lds + kdst) = k0_; *(LAS u32x4*)(lds + RV + vdstr0) = v0_; *(LAS u32x4*)(lds + RV + vdstr1) = v1_; }
        __builtin_amdgcn_sched_barrier(0);
        kR = *(const u32x4*)(ksrc + (size_t)64 * 2048); vR0 = *(const u32x4*)(vsrc0 + 64); vR1 = *(const u32x4*)(vsrc1 + 64);
        __syncthreads();
#define PBAR() do { asm volatile("s_waitcnt lgkmcnt(0)" ::: "memory"); __builtin_amdgcn_s_barrier(); asm volatile("" ::: "memory"); } while (0)
        const bool lag = (wid >= 4);
        if (lag) PBAR();
        f32x16 s0, s1; bf16x8 pf_[4];
#define QKT(slot) do { const int kcur_ = (slot) * KS_BYTES; \
            _Pragma("unroll") for (int r = 0; r < 16; ++r) { s0[r] = 0.f; s1[r] = 0.f; } \
            _Pragma("unroll") for (int dd = 0; dd < 4; ++dd) { \
                const bf16x8 qp_ = *(const LAS bf16x8*)(lds + qoff + dd * 1024); \
                const bf16x8 kf0_ = *(const LAS bf16x8*)(lds + kcur_ + kfo + dd * 32), kf1_ = *(const LAS bf16x8*)(lds + kcur_ + kfo + 32 * KPITCH + dd * 32); \
                __builtin_amdgcn_sched_barrier(0); \
                s0 = __builtin_amdgcn_mfma_f32_32x32x16_bf16(kf0_, qp_, s0, 0, 0, 0); s1 = __builtin_amdgcn_mfma_f32_32x32x16_bf16(kf1_, qp_, s1, 0, 0, 0); \
                __builtin_amdgcn_sched_barrier(0); } } while (0)
#define PVM(slot) do { const int vcur_ = RV + (slot) * VS_BYTES; \
            _Pragma("unroll") for (int g = 0; g < 4; ++g) { \
                bf16x8 vf_[4]; \
                _Pragma("unroll") for (int i = 0; i < 4; ++i) vf_[i] = *(const LAS bf16x8*)(lds + vcur_ + vfr + (2 * (g >> 1) + (i & 1)) * 32 * KPITCH + (2 * (g & 1) + (i >> 1)) * 32); \
                __builtin_amdgcn_sched_barrier(0); \
                _Pragma("unroll") for (int i = 0; i < 4; ++i) O[2 * (g >> 1) + (i & 1)] = __builtin_amdgcn_mfma_f32_32x32x16_bf16(vf_[i], pf_[2 * (g & 1) + (i >> 1)], O[2 * (g >> 1) + (i & 1)], 0, 0, 0); \
                __builtin_amdgcn_sched_barrier(0); } } while (0)
#define VLD(dst, g) do { _Pragma("unroll") for (int i = 0; i < 4; ++i) dst[i] = *(const LAS bf16x8*)(lds + vcur_ + vfr + (2 * ((g) >> 1) + (i & 1)) * 32 * KPITCH + (2 * ((g) & 1) + (i >> 1)) * 32); } while (0)
#define VMM(src, g) do { _Pragma("unroll") for (int i = 0; i < 4; ++i) O[2 * ((g) >> 1) + (i & 1)] = __builtin_amdgcn_mfma_f32_32x32x16_bf16(src[i], pf_[2 * ((g) & 1) + (i >> 1)], O[2 * ((g) >> 1) + (i & 1)], 0, 0, 0); } while (0)
#define KLD(kd, qd, h2) do { _Pragma("unroll") for (int d2 = 0; d2 < 2; ++d2) { const int dd = 2 * (h2) + d2; qd[d2] = *(const LAS bf16x8*)(lds + qoff + dd * 1024); \
            kd[2 * d2] = *(const LAS bf16x8*)(lds + kcur_ + kfo + dd * 32); kd[2 * d2 + 1] = *(const LAS bf16x8*)(lds + kcur_ + kfo + 32 * KPITCH + dd * 32); } } while (0)
#define KMM(kd, qd) do { _Pragma("unroll") for (int d2 = 0; d2 < 2; ++d2) { s0 = __builtin_amdgcn_mfma_f32_32x32x16_bf16(kd[2 * d2], qd[d2], s0, 0, 0, 0); s1 = __builtin_amdgcn_mfma_f32_32x32x16_bf16(kd[2 * d2 + 1], qd[d2], s1, 0, 0, 0); } } while (0)
#define SB() __builtin_amdgcn_sched_barrier(0)
#define APHASE(vslot, kslot, DOPV, DOQK) do { const int vcur_ = RV + (vslot) * VS_BYTES, kcur_ = (kslot) * KS_BYTES; \
            bf16x8 ga_[4], gb_[4], ka_[4], qa_[2], kb_[4], qb_[2]; \
            if (DOPV) { VLD(ga_, 0); VLD(gb_, 1); SB(); VMM(ga_, 0); SB(); VLD(ga_, 2); SB(); VMM(gb_, 1); SB(); VLD(gb_, 3); SB(); VMM(ga_, 2); SB(); } \
            if (DOQK) { KLD(ka_, qa_, 0); SB(); } \
            if (DOPV) { VMM(gb_, 3); SB(); } \
            if (DOQK) { KLD(kb_, qb_, 1); SB(); \
                _Pragma("unroll") for (int r = 0; r < 16; ++r) { s0[r] = 0.f; s1[r] = 0.f; } \
                KMM(ka_, qa_); SB(); KMM(kb_, qb_); SB(); } } while (0)
#define SOFTMAX(t) do { \
            const float base_ = (float)((t) * 64 + 8 * hi - qpos); \
            float mx_ = -1e30f; \
            { float x0_ = base_, x1_ = base_ + 32.0f; \
              _Pragma("unroll") for (int r = 0; r < 16; ++r) { \
                if (r == 8) { x0_ = base_ + 16.0f; x1_ = base_ + 48.0f; } \
                s0[r] = s0[r] - c2 * fabsf(x0_); s1[r] = s1[r] - c2 * fabsf(x1_); \
                mx_ = fmaxf(mx_, fmaxf(s0[r], s1[r])); x0_ += 1.0f; x1_ += 1.0f; } } \
            mx_ = swap_max(mx_); \
            __builtin_amdgcn_sched_barrier(0); \
            const float mnew_ = fmaxf(mrun, mx_); \
            if (__any(mnew_ > mrun)) { \
                const float alpha_ = __builtin_amdgcn_exp2f(mrun - mnew_); lrun *= alpha_; \
                _Pragma("unroll") for (int db = 0; db < 4; ++db) _Pragma("unroll") for (int r = 0; r < 16; ++r) O[db][r] *= alpha_; \
                mrun = mnew_; } \
            __builtin_amdgcn_sched_barrier(0); \
            float ls_ = 0.f; \
            _Pragma("unroll") for (int r = 0; r < 16; ++r) { s0[r] = __builtin_amdgcn_exp2f(s0[r] - mrun); s1[r] = __builtin_amdgcn_exp2f(s1[r] - mrun); ls_ += s0[r] + s1[r]; } \
            lrun += ls_; \
            __builtin_amdgcn_sched_barrier(0); \
            { u32x4 w_; \
              w_.x = cvt_pk_bf16(s0[0], s0[1]); w_.y = cvt_pk_bf16(s0[2], s0[3]); w_.z = cvt_pk_bf16(s0[4], s0[5]); w_.w = cvt_pk_bf16(s0[6], s0[7]); pf_[0] = __builtin_bit_cast(bf16x8, w_); \
              w_.x = cvt_pk_bf16(s0[8], s0[9]); w_.y = cvt_pk_bf16(s0[10], s0[11]); w_.z = cvt_pk_bf16(s0[12], s0[13]); w_.w = cvt_pk_bf16(s0[14], s0[15]); pf_[1] = __builtin_bit_cast(bf16x8, w_); \
              w_.x = cvt_pk_bf16(s1[0], s1[1]); w_.y = cvt_pk_bf16(s1[2], s1[3]); w_.z = cvt_pk_bf16(s1[4], s1[5]); w_.w = cvt_pk_bf16(s1[6], s1[7]); pf_[2] = __builtin_bit_cast(bf16x8, w_); \
              w_.x = cvt_pk_bf16(s1[8], s1[9]); w_.y = cvt_pk_bf16(s1[10], s1[11]); w_.z = cvt_pk_bf16(s1[12], s1[13]); w_.w = cvt_pk_bf16(s1[14], s1[15]); pf_[3] = __builtin_bit_cast(bf16x8, w_); } \
            __builtin_amdgcn_sched_barrier(0); } while (0)
#define STAGE_WRITE(slot) do { *(LAS u32x4*)(lds + (slot) * KS_BYTES + kdst) = kR; *(LAS u32x4*)(lds + RV + (slot) * VS_BYTES + vdstr0) = vR0; *(LAS u32x4*)(lds + RV + (slot) * VS_BYTES + vdstr1) = vR1; } while (0)
        APHASE(0, 0, false, true); STAGE_WRITE(1); PBAR();
        int sc = 0, sn = 1, sw = 2;
#pragma unroll 1
        for (int t = 0; t < 63; ++t) {
            if (t + 2 < 64) { kR = *(const u32x4*)(ksrc + (size_t)(t + 2) * 64 * 2048); vR0 = *(const u32x4*)(vsrc0 + (t + 2) * 64); vR1 = *(const u32x4*)(vsrc1 + (t + 2) * 64); }
            SOFTMAX(t); PBAR();
            APHASE(sc, sn, true, true);
            if (t + 2 < 64) STAGE_WRITE(sw);
            PBAR();
            { const int t_ = sc; sc = sn; sn = sw; sw = t_; }
        }
        SOFTMAX(63); PBAR();
        APHASE(sc, 0, true, false); PBAR();
        if (!lag) PBAR();
#undef STAGE_WRITE
#undef SOFTMAX
#undef PVM
#undef APHASE
#undef VLD
#undef VMM
#undef KLD
#undef KMM
#undef SB
#undef QKT
#undef PBAR
        const float inv = 1.0f / swap_sum(lrun);
        bf16_t* orow = opm + (rowbase + qpos) * 2048 + h * 128 + 4 * hi;
        if (c == 0) {
#pragma unroll
            for (int db = 0; db < 4; ++db)
#pragma unroll
                for (int g = 0; g < 4; ++g) { u32x2 w; w.x = cvt_pk_bf16(O[db][4 * g] * inv, O[db][4 * g + 1] * inv); w.y = cvt_pk_bf16(O[db][4 * g + 2] * inv, O[db][4 * g + 3] * inv);
                    *(u32x2*)(orow + 32 * db + 8 * g) = w; }
        } else {
            float ss = 0.f;
#pragma unroll
            for (int db = 0; db < 4; ++db) {
#pragma unroll
                for (int g = 0; g < 4; ++g) { const u32x2 w = *(const u32x2*)(orow + 32 * db + 8 * g); const int r = 4 * g;
                    const float a0 = bf_lo(w.x) - lam * (O[db][r] * inv), a1 = bf_hi(w.x) - lam * (O[db][r + 1] * inv), a2 = bf_lo(w.y) - lam * (O[db][r + 2] * inv), a3 = bf_hi(w.y) - lam * (O[db][r + 3] * inv);
                    O[db][r] = a0; O[db][r + 1] = a1; O[db][r + 2] = a2; O[db][r + 3] = a3; ss = fmaf(a0, a0, ss); ss = fmaf(a1, a1, ss); ss = fmaf(a2, a2, ss); ss = fmaf(a3, a3, ss);
                    asm volatile("" : "+v"(ss)); __builtin_amdgcn_sched_barrier(0); } }
            ss = swap_sum(ss);
            const float rn = (1.0f - LAMBDA_INIT) / sqrtf(ss * (1.0f / 128.0f) + SUBLN_EPS);
#pragma unroll
            for (int db = 0; db < 4; ++db)
#pragma unroll
                for (int g = 0; g < 4; ++g) { const int d = 32 * db + 8 * g;
                    const f32x4 gn = *(const f32x4*)(subln_ + d + 4 * hi);
                    u32x2 w; w.x = cvt_pk_bf16(O[db][4 * g] * rn * gn[0], O[db][4 * g + 1] * rn * gn[1]); w.y = cvt_pk_bf16(O[db][4 * g + 2] * rn * gn[2], O[db][4 * g + 3] * rn * gn[3]);
                    *(u32x2*)(orow + d) = w; }
        }
    }
}

#if defined(DBG_STOP)
__device__ __forceinline__ void dbg_dump(const Args& a, int k) {
    const size_t gt = (size_t)blockIdx.x * NTHR + threadIdx.x, NGT = (size_t)gridDim.x * NTHR;
    const bf16_t* b16 = (const bf16_t*)a.ws;
    for (size_t i = gt; i < (size_t)M * DM; i += NGT) {
        const size_t row = i / DM, col = i % DM; float v = 0.f;
        auto B = [&](size_t off, size_t idx) { return __uint_as_float((unsigned)((const bf16_t*)(a.ws + off))[idx] << 16); };
        if (k == 0) { v = B(WS_WIN, i % ((size_t)8192 * 2048)); }
        if (k == 1 && DBG_SEL == 1) { v = B(WS_GATES, row * 4096 + col) + B(WS_GATES, row * 4096 + 2048 + col); }
        if (k == 1 && DBG_SEL == 3) { v = B(WS_QK, i); }
        if (k == 1 && DBG_SEL == 4) { v = B(WS_PZ, row * 1024 + (col & 1023)) + B(WS_VT, row * 1024 + (col & 1023)); }
        if (k == 1 && DBG_SEL == 2) { v = B(WS_WCAT, i % ((size_t)2048 * 2048)); }
        if (k == 1 && DBG_SEL == 0) { v = B(WS_QK, i) + B(WS_PZ, row * 1024 + (col & 1023)) + B(WS_VT, row * 1024 + (col & 1023)) + B(WS_GATES, row * 4096 + col) + B(WS_GATES, row * 4096 + 2048 + col) + B(WS_WCAT, i % ((size_t)2048 * 2048)); }
        if (k == 2) { v = B(WS_OPM, i); }
        if (k == 3) { v = B(WS_MERGED, i) + B(WS_T, i); }
        if (k == 4) { v = ((const float*)(a.ws + WS_MO))[i]; }
        if (k == 5) { v = a.out[i] + B(WS_H2, i); }
        if (k == 6) { v = B(WS_U, row * UPC + col) + B(WS_U, row * UPC + 2048 + col) + B(WS_U, row * UPC + 4096 + col) + B(WS_U, row * UPC + 6144 + col) + B(WS_U, row * UPC + 8192 + col) + B(WS_U, row * UPC + 9216 + col) + B(WS_SIDE, i % ((size_t)1024 * 5632)); }
        if (k == 7) { v = B(WS_U, row * UPC + col) + B(WS_U, row * UPC + 2048 + col) + B(WS_U, row * UPC + 4096 + col) + B(WS_U, row * UPC + 6144 + col) + B(WS_U, row * UPC + 8192 + col) + B(WS_U, row * UPC + 9216 + col); }
        if (k == 8) { v = ((const float*)(a.ws + WS_Y))[i]; }
        a.out[i] = v;
    }
}
#endif

#define XB_TMO      128
#define XB_XCNT(j)  (256  + 64 * (j))
#define XB_XSUB(j)  (1280 + 64 * (j))
#define XB_XGEN(j)  (2304 + 64 * (j))
#define XB_TOP      3328
#define XB_TOPGEN   3392
#define XCD_BAR_WORDS 3456
#define XB_SPIN_CAP (1u << 18)
__device__ __forceinline__ unsigned xb_ld(unsigned* p)              { return __hip_atomic_load(p, __ATOMIC_RELAXED, __HIP_MEMORY_SCOPE_AGENT); }
__device__ __forceinline__ unsigned xb_add(unsigned* p, unsigned v) { return __hip_atomic_fetch_add(p, v, __ATOMIC_RELAXED, __HIP_MEMORY_SCOPE_AGENT); }
__device__ __forceinline__ unsigned xb_xcc_id() { return (unsigned)__builtin_amdgcn_s_getreg((3 << 11) | 20) & 0xFu; }
#define XB_SPIN(cond, bar) do { unsigned _sp = 0; while (cond) { __builtin_amdgcn_s_sleep(1); \
    if ((++_sp & 255u) == 0u) { if (xb_ld(&(bar)[XB_TMO])) break; if (_sp > XB_SPIN_CAP) { atomicAdd(&(bar)[XB_TMO], 1u); break; } } } } while (0)
__device__ __forceinline__ void xcd_barrier_complete(unsigned* bar, unsigned x, unsigned& nloc, unsigned& nx) {
    const unsigned G = gridDim.x * gridDim.y * gridDim.z;
    unsigned sum, cnt, mine, sp = 0u;
    for (;;) {
        sum = 0u; cnt = 0u; mine = 0u;
#pragma unroll
        for (unsigned j = 0; j < 16; ++j) { const unsigned c = xb_ld(&bar[XB_XCNT(j)]); sum += c; cnt += (c > 0u) ? 1u : 0u; mine = (j == x) ? c : mine; }
        if (sum == G) break;
        __builtin_amdgcn_s_sleep(1);
        if ((++sp & 255u) == 0u) { if (xb_ld(&bar[XB_TMO])) break; if (sp > XB_SPIN_CAP) { atomicAdd(&bar[XB_TMO], 1u); break; } }
    }
    nloc = mine > 0u ? mine : 1u; nx = cnt > 0u ? cnt : 1u;
}
__device__ __forceinline__ void xcd_barrier(unsigned* bar, unsigned x, volatile LAS unsigned* st, bool tid0) {
    asm volatile("s_waitcnt vmcnt(0)" ::: "memory");
    __syncthreads();
    if (tid0) {
        __builtin_amdgcn_s_waitcnt(0);
        unsigned nloc = st[0], nx = st[1];
        if (nloc == 0u) { xcd_barrier_complete(bar, x, nloc, nx); st[0] = nloc; st[1] = nx; }
        const unsigned old = xb_add(&bar[XB_XSUB(x)], 1u);
        const unsigned gen = old / nloc;
        if (old + 1u == (gen + 1u) * nloc) {
            __builtin_amdgcn_fence(__ATOMIC_RELEASE, "agent");
            asm volatile("s_waitcnt vmcnt(0)" ::: "memory");
            const unsigned og = xb_add(&bar[XB_TOP], 1u);
            const unsigned tg = og / nx;
            if (og + 1u == (tg + 1u) * nx) xb_add(&bar[XB_TOPGEN], 1u);
            else XB_SPIN(xb_ld(&bar[XB_TOPGEN]) == tg, bar);
            __builtin_amdgcn_fence(__ATOMIC_ACQUIRE, "agent");
            xb_add(&bar[XB_XGEN(x)], 1u);
            asm volatile("s_waitcnt vmcnt(0)" ::: "memory");
        } else {
            XB_SPIN(xb_ld(&bar[XB_XGEN(x)]) == gen, bar);
            __builtin_amdgcn_fence(__ATOMIC_ACQUIRE, "agent");
            asm volatile("s_waitcnt vmcnt(0)" ::: "memory");
        }
    }
    __syncthreads();
}

__device__ unsigned g_bar[64];
__global__ void __launch_bounds__(NTHR, 2) fwd_kernel(Args a) {
    extern __shared__ __attribute__((aligned(16))) unsigned char lds_raw[];
    LAS unsigned char* lds = (LAS unsigned char*)lds_raw;
    cg::grid_group grid = cg::this_grid();
    const int G = gridDim.x, bx = blockIdx.x;
    const int wave0 = __builtin_amdgcn_readfirstlane((int)threadIdx.x >> 6);
    const int vcu = (G % 8 == 0) ? (bx % 8) * (G / 8) + bx / 8 : bx;
    const int NGW = G * NWAVES, NGT = G * NTHR;
    unsigned* const xb_bar = (unsigned*)(a.ws + WS_CTL);
    volatile LAS unsigned* const xb_st = (volatile LAS unsigned*)(lds + LDS_BYTES - 64);
    const unsigned xb_x = xb_xcc_id();
    if (MY_TID(wave0) == 0) { xb_st[0] = 0u; xb_st[1] = 0u; (void)xb_add(&xb_bar[XB_XCNT(xb_x)], 1u); }
    __syncthreads();
    if (a.ws == nullptr) grid.sync();
#define GRID_SYNC() xcd_barrier(xb_bar, xb_x, xb_st, MY_TID(wave0) == 0)
#define PHASE_VIEW() \
    int tid_ = MY_TID(wave0); asm volatile("" : "+v"(tid_)); const int tid = tid_, lane = tid & 63, wave = wave0; \
    const int gw = vcu * NWAVES + wave, gt = bx * NTHR + tid; (void)gw; (void)gt; (void)lane; \
    __attribute__((address_space(1))) unsigned char* ws = (__attribute__((address_space(1))) unsigned char*)a.ws; asm volatile("" : "+s"(ws));     \
    bf16_t* WdownT = (bf16_t*)(ws + WS_WDOWN); bf16_t* WinT = (bf16_t*)(ws + WS_WIN); bf16_t* WoutT = (bf16_t*)(ws + WS_WOUT); \
    bf16_t* WcatT = (bf16_t*)(ws + WS_WCAT); bf16_t* WpT = (bf16_t*)(ws + WS_WPT); bf16_t* PWs = (bf16_t*)(ws + WS_PWS); \
    bf16_t* Hb = (bf16_t*)(ws + WS_H); bf16_t* OPM = (bf16_t*)(ws + WS_OPM); bf16_t* QK = (bf16_t*)(ws + WS_QK); bf16_t* MERGED = (bf16_t*)(ws + WS_MERGED); \
    bf16_t* VT = (bf16_t*)(ws + WS_VT); bf16_t* PZ = (bf16_t*)(ws + WS_PZ); bf16_t* Tb = (bf16_t*)(ws + WS_T); bf16_t* GATES = (bf16_t*)(ws + WS_GATES); \
    float* MO = (float*)(ws + WS_MO); bf16_t* H2 = (bf16_t*)(ws + WS_H2); bf16_t* WupT = (bf16_t*)(ws + WS_WUP); bf16_t* U = (bf16_t*)(ws + WS_U); \
    bf16_t* SIDE = (bf16_t*)(ws + WS_SIDE); float* Y = (float*)(ws + WS_Y); \
    (void)WdownT; (void)WinT; (void)WoutT; (void)WcatT; (void)WpT; (void)PWs; (void)Hb; (void)OPM; (void)QK; (void)MERGED; (void)VT; (void)PZ; (void)Tb; (void)GATES; (void)MO; (void)H2; (void)WupT; (void)U; (void)SIDE; (void)Y;

    if (PH(0)) { PHASE_VIEW()
        LAS float* scr = (LAS float*)(lds + wave * 16384);
        constexpr int I_IN = (DM / 64) * (INC / 32), I_UP = (DM / 64) * (UPC / 32), I_DN = (DFF / 64) * (DM / 32), I_OUT = (DM / 64) * (DM / 32), I_AT = (1024 / 64) * (DM / 32), I_PB = I_AT;
        constexpr int NITEMS = I_IN + I_UP + I_DN + I_OUT + I_AT + I_PB;
        for (int it = gw; it < NITEMS; it += NGW) {
            int r = it;
            if (r < I_IN) { transpose_item<0>(a.w_in, DM, INC, WinT, DM, scr, r, lane); continue; } r -= I_IN;
            if (r < I_UP) { transpose_item<1>(a.w_up, DM, UPC, WupT, DM, scr, r, lane); continue; } r -= I_UP;
            if (r < I_DN) { transpose_item<0>(a.w_down, DFF, DM, WdownT, DFF, scr, r, lane); continue; } r -= I_DN;
            if (r < I_OUT) { transpose_item<0>(a.w_out, DM, DM, WoutT, DM, scr, r, lane); continue; } r -= I_OUT;
            if (r < I_AT) { transpose_item<0>(a.w_attn, 1024, DM, WcatT, DM, scr, r, lane); continue; } r -= I_AT;
            transpose_item<0>(a.w_poolb, 1024, DM, WpT, 1024, scr, r, lane);
        }
        for (int i = gt; i < 1024 * 256 / 4; i += NGT) { const int e = i * 4, gcl = e >> 8, dp = e & 255, g = gcl >> 8;
            const f32x4 w = *(const f32x4*)(a.pool_w + e), sc = *(const f32x4*)(a.pool_scale + g * 256 + dp); const f32x4 o = w * sc;
            u32x2 p; p.x = cvt_pk_bf16(o[0], o[1]); p.y = cvt_pk_bf16(o[2], o[3]); *(u32x2*)(PWs + e) = p; }
        for (int m = gw; m < M; m += NGW) rms_row_bf16(a.x + (size_t)m * DM, a.g_pre_mix, Hb + (size_t)m * DM, lane);
    }
    GRID_SYNC();
#if defined(DBG_STOP)
    if (DBG_STOP == 0) { dbg_dump(a, 0); return; }
#endif

    if (PH(1)) { PHASE_VIEW()
#ifndef NO_MINI
        {
            pg8::Gemm gm{WpT, PWs, 1024, 256, 256, 256, 512};
            pg8::StaticOrder S; S.init(DM, 1024, G, bx);
            pg8::EpiBf16<false> E{WcatT + 1024, DM, nullptr};
            pg8::gemm_phase(lds, gm, S, E, wave0);
        }
#endif
#ifndef NO_Z
        pg8::Gemm gm{Hb, WinT, DM, DM, DM, 256, 0};
        pg8::StaticOrder S; S.init(M, INC, G, bx);
        pg8::EpiZ E{QK, VT, PZ, GATES, a.b_gate, 0.125f * LOG2E};
        pg8::gemm_phase(lds, gm, S, E, wave0);
#endif
    }
    GRID_SYNC();
#if defined(DBG_STOP)
    if (DBG_STOP == 1) { dbg_dump(a, 1); return; }
#endif

    if (PH(2)) { PHASE_VIEW()
        for (int i = gt; i < (M / 16) * 128; i += NGT) {
            const int vec = i & 127, rb = i >> 7, g = vec >> 5, half = 1 << g, row0 = rb * 16, s0 = row0 & (SEQ - 1);
            const bf16_t* base = PZ + (size_t)(row0 - s0) * 1024 + vec * 8;
            bf16_t* outp = OPM + (size_t)row0 * 2048 + 1024 + vec * 8;
            int lo = (s0 - half < 0) ? 0 : s0 - half, hi_ = (s0 + half > SEQ) ? SEQ : s0 + half;
            float acc[8];
#pragma unroll
            for (int j = 0; j < 8; ++j) acc[j] = 0.f;
            for (int r = lo; r < hi_; ++r) { const u32x4 w = *(const u32x4*)(base + (size_t)r * 1024);
                acc[0] += bf_lo(w.x); acc[1] += bf_hi(w.x); acc[2] += bf_lo(w.y); acc[3] += bf_hi(w.y); acc[4] += bf_lo(w.z); acc[5] += bf_hi(w.z); acc[6] += bf_lo(w.w); acc[7] += bf_hi(w.w); }
#pragma unroll 4
            for (int k = 0; k < 16; ++k) {
                const int s = s0 + k;
                const u32x4 w = *(const u32x4*)(base + (size_t)s * 1024);
                const float ic = 1.0f / (float)(hi_ - lo);
                u32x4 o;
                o.x = cvt_pk_bf16(acc[0] * ic - bf_lo(w.x), acc[1] * ic - bf_hi(w.x)); o.y = cvt_pk_bf16(acc[2] * ic - bf_lo(w.y), acc[3] * ic - bf_hi(w.y));
                o.z = cvt_pk_bf16(acc[4] * ic - bf_lo(w.z), acc[5] * ic - bf_hi(w.z)); o.w = cvt_pk_bf16(acc[6] * ic - bf_lo(w.w), acc[7] * ic - bf_hi(w.w));
                *(u32x4*)(outp + (size_t)k * 2048) = o;
                if (s - half >= 0) { const u32x4 q = *(const u32x4*)(base + (size_t)(s - half) * 1024);
                    acc[0] -= bf_lo(q.x); acc[1] -= bf_hi(q.x); acc[2] -= bf_lo(q.y); acc[3] -= bf_hi(q.y); acc[4] -= bf_lo(q.z); acc[5] -= bf_hi(q.z); acc[6] -= bf_lo(q.w); acc[7] -= bf_hi(q.w); ++lo; }
                if (s + half < SEQ) { const u32x4 q = *(const u32x4*)(base + (size_t)(s + half) * 1024);
                    acc[0] += bf_lo(q.x); acc[1] += bf_hi(q.x); acc[2] += bf_lo(q.y); acc[3] += bf_hi(q.y); acc[4] += bf_lo(q.z); acc[5] += bf_hi(q.z); acc[6] += bf_lo(q.w); acc[7] += bf_hi(q.w); ++hi_; }
            }
        }
        const float d1 = wave_sum(a.lq1[lane] * a.lk1[lane]), d2 = wave_sum(a.lq2[lane] * a.lk2[lane]);
        const float lam = expf(d1) - expf(d2) + LAMBDA_INIT;
        for (int uidx = vcu; uidx < NB * NH * 16; uidx += G) {
            const int bh = uidx >> 4, qb = uidx & 15, b = bh >> 3, h = bh & 7;
            const float c2 = exp2f(-(float)(h + 1)) * LOG2E;
            attn_unit(lds, QK, VT, OPM, a.subln, b, h, qb, lam, c2, wave0);
        }
    }
    GRID_SYNC();
#if defined(DBG_STOP)
    if (DBG_STOP == 2) { dbg_dump(a, 2); return; }
#endif

    if (PH(3)) { PHASE_VIEW()
        pg8::StaticOrder S; S.init(M, DM, G, bx);
        { pg8::Gemm gm{OPM, WcatT, DM, DM, DM, 256, 0}; pg8::EpiGateMid E{GATES, MERGED}; pg8::gemm_phase(lds, gm, S, E, wave0); }
    }
    GRID_SYNC();
#if defined(DBG_STOP)
    if (DBG_STOP == 3) { dbg_dump(a, 3); return; }
#endif

    if (PH(4)) { PHASE_VIEW()
        pg8::Gemm gm{MERGED, WoutT, DM, DM, DM, 256, 0}; pg8::StaticOrder S; S.init(M, DM, G, bx);
        pg8::EpiF32 E{MO, DM}; pg8::gemm_phase(lds, gm, S, E, wave0);
    }
    GRID_SYNC();
#if defined(DBG_STOP)
    if (DBG_STOP == 4) { dbg_dump(a, 4); return; }
#endif

    if (PH(5)) { PHASE_VIEW()
    for (int m = gw; m < M; m += NGW) {
        const float* mor = MO + (size_t)m * DM; const float* xr = a.x + (size_t)m * DM; float* o = a.out + (size_t)m * DM; bf16_t* h2r = H2 + (size_t)m * DM;
        f32x4 v[8]; float s = 0.f;
#pragma unroll
        for (int j = 0; j < 8; ++j) { v[j] = __builtin_nontemporal_load((const f32x4*)(mor + 256 * j + 4 * lane)); s += (v[j][0] * v[j][0] + v[j][1] * v[j][1]) + (v[j][2] * v[j][2] + v[j][3] * v[j][3]); }
        const float rs = 1.0f / sqrtf(wave_sum(s) * (1.0f / DM) + NORM_EPS);
        float s2 = 0.f;
#pragma unroll
        for (int j = 0; j < 8; ++j) { const f32x4 gg = *(const f32x4*)(a.g_post_mix + 256 * j + 4 * lane), xx = __builtin_nontemporal_load((const f32x4*)(xr + 256 * j + 4 * lane));
            v[j] = xx + v[j] * rs * gg; *(f32x4*)(o + 256 * j + 4 * lane) = v[j];
            s2 += (v[j][0] * v[j][0] + v[j][1] * v[j][1]) + (v[j][2] * v[j][2] + v[j][3] * v[j][3]); }
        const float rs2 = 1.0f / sqrtf(wave_sum(s2) * (1.0f / DM) + NORM_EPS);
#pragma unroll
        for (int j = 0; j < 8; ++j) { const f32x4 gg = *(const f32x4*)(a.g_pre_ffn + 256 * j + 4 * lane); const f32x4 q = v[j] * rs2 * gg;
            u32x2 w; w.x = cvt_pk_bf16(q[0], q[1]); w.y = cvt_pk_bf16(q[2], q[3]); *(u32x2*)(h2r + 256 * j + 4 * lane) = w; }
    } }
    GRID_SYNC();
#if defined(DBG_STOP)
    if (DBG_STOP == 5) { dbg_dump(a, 5); return; }
#endif

    if (PH(6)) { PHASE_VIEW()
        pg8::Gemm gm{H2, WupT, DM, DM, DM, 256, 0}; pg8::StaticOrder S; S.init(M, UPC, G, bx);
        pg8::EpiConv E{U, SIDE, a.conv_w, a.conv_b, lds + pg8::STAGE_BYTES}; pg8::gemm_phase(lds, gm, S, E, wave0);
    }
    GRID_SYNC();
#if defined(DBG_STOP)
    if (DBG_STOP == 6) { dbg_dump(a, 6); return; }
#endif

    if (PH(7)) { PHASE_VIEW()
    for (int it = gt; it < 256 * 2 * 704; it += NGT) {
        const int v8 = it % 704, which = (it / 704) & 1, k = it / 1408, ch = 8 * v8;
        const int r = which ? 64 * k + 63 : 64 * k;
        const bool seq_first = (r & (SEQ - 1)) == 0, seq_last = ((r + 1) & (SEQ - 1)) == 0;
        const bf16_t* sk = SIDE + (size_t)k * 4 * UPC + ch;
        const bf16_t* pp = which ? sk + 2 * UPC : (seq_first ? sk : sk - UPC);
        const bf16_t* pc = which ? sk + 3 * UPC : sk;
        const bf16_t* pn = which ? (seq_last ? sk : sk + 4 * UPC) : sk + UPC;
        const bool zp = (!which) && seq_first, zn = which && seq_last;
        const u32x4 z4 = {0u, 0u, 0u, 0u};
        u32x4 gp = *(const u32x4*)pp, gc = *(const u32x4*)pc, gn = *(const u32x4*)pn, vp = *(const u32x4*)(pp + DFF), vc = *(const u32x4*)(pc + DFF), vn = *(const u32x4*)(pn + DFF);
        if (zp) { gp = z4; vp = z4; } if (zn) { gn = z4; vn = z4; }
        const unsigned gpw[4] = {gp.x, gp.y, gp.z, gp.w}, gcw[4] = {gc.x, gc.y, gc.z, gc.w}, gnw[4] = {gn.x, gn.y, gn.z, gn.w};
        const unsigned vpw[4] = {vp.x, vp.y, vp.z, vp.w}, vcw[4] = {vc.x, vc.y, vc.z, vc.w}, vnw[4] = {vn.x, vn.y, vn.z, vn.w};
        float tg[3][8], tv[3][8], tb[2][8];
#pragma unroll
        for (int k3 = 0; k3 < 3; ++k3)
#pragma unroll
            for (int hq = 0; hq < 2; ++hq) { const f32x4 x = *(const f32x4*)(a.conv_w + (size_t)k3 * UPC + ch + 4 * hq), y = *(const f32x4*)(a.conv_w + (size_t)k3 * UPC + DFF + ch + 4 * hq);
#pragma unroll
                for (int e = 0; e < 4; ++e) { tg[k3][4 * hq + e] = x[e]; tv[k3][4 * hq + e] = y[e]; } }
#pragma unroll
        for (int hq = 0; hq < 2; ++hq) { const f32x4 x = *(const f32x4*)(a.conv_b + ch + 4 * hq), y = *(const f32x4*)(a.conv_b + DFF + ch + 4 * hq);
#pragma unroll
            for (int e = 0; e < 4; ++e) { tb[0][4 * hq + e] = x[e]; tb[1][4 * hq + e] = y[e]; } }
        unsigned ow[4];
#pragma unroll
        for (int q = 0; q < 4; ++q) {
            const int e0 = 2 * q, e1 = e0 + 1;
            const float g0 = tg[0][e0] * bf_lo(gpw[q]) + tg[1][e0] * bf_lo(gcw[q]) + tg[2][e0] * bf_lo(gnw[q]) + tb[0][e0];
            const float g1 = tg[0][e1] * bf_hi(gpw[q]) + tg[1][e1] * bf_hi(gcw[q]) + tg[2][e1] * bf_hi(gnw[q]) + tb[0][e1];
            const float x0 = tv[0][e0] * bf_lo(vpw[q]) + tv[1][e0] * bf_lo(vcw[q]) + tv[2][e0] * bf_lo(vnw[q]) + tb[1][e0];
            const float x1 = tv[0][e1] * bf_hi(vpw[q]) + tv[1][e1] * bf_hi(vcw[q]) + tv[2][e1] * bf_hi(vnw[q]) + tb[1][e1];
            ow[q] = cvt_pk_bf16(gelu_tanh(g0) * x0, gelu_tanh(g1) * x1);
        }
        u32x4 o; o.x = ow[0]; o.y = ow[1]; o.z = ow[2]; o.w = ow[3];
        *(u32x4*)(U + (size_t)r * DFF + ch) = o;
    } }
    GRID_SYNC();
#if defined(DBG_STOP)
    if (DBG_STOP == 7) { dbg_dump(a, 7); return; }
#endif

    if (PH(8)) { PHASE_VIEW()
        pg8::Gemm gm{U, WdownT, DFF, DFF, DFF, 256, 0}; pg8::StaticOrder S; S.init(M, DM, G, bx);
        pg8::EpiF32 E{Y, DM}; pg8::gemm_phase(lds, gm, S, E, wave0);
    }
    GRID_SYNC();
#if defined(DBG_STOP)
    if (DBG_STOP == 8) { dbg_dump(a, 8); return; }
#endif

    if (PH(9)) { PHASE_VIEW()
    for (int m = gw; m < M; m += NGW) {
        const float* yr = Y + (size_t)m * DM; float* o = a.out + (size_t)m * DM;
        f32x4 v[8]; float s = 0.f;
#pragma unroll
        for (int j = 0; j < 8; ++j) { v[j] = __builtin_nontemporal_load((const f32x4*)(yr + 256 * j + 4 * lane)); s += (v[j][0] * v[j][0] + v[j][1] * v[j][1]) + (v[j][2] * v[j][2] + v[j][3] * v[j][3]); }
        const float rs = 1.0f / sqrtf(wave_sum(s) * (1.0f / DM) + NORM_EPS);
#pragma unroll
        for (int j = 0; j < 8; ++j) { const f32x4 gg = *(const f32x4*)(a.g_post_ffn + 256 * j + 4 * lane), xx = *(const f32x4*)(o + 256 * j + 4 * lane);
            *(f32x4*)(o + 256 * j + 4 * lane) = xx + v[j] * rs * gg; }
    } }
}

extern "C" void kernel_launch(void* const* d_in, const int* in_sizes, int n_in, void* d_out, int out_size, void* d_ws, size_t ws_size, hipStream_t stream) {
    static int grid = 0;
    if (grid == 0) {
        if (n_in != 21 || in_sizes[0] != M * DM || out_size != M * DM || ws_size < WS_NEED) { fprintf(stderr, "kernel_launch: unexpected shapes / workspace (n_in %d, ws %zu)\n", n_in, ws_size); grid = -1; return; }
        int dev = 0, cus = 0, per_cu = 0;
        (void)hipGetDevice(&dev);
        (void)hipDeviceGetAttribute(&cus, hipDeviceAttributeMultiprocessorCount, dev);
        if (hipFuncSetAttribute((const void*)fwd_kernel, hipFuncAttributeMaxDynamicSharedMemorySize, LDS_BYTES) != hipSuccess) { fprintf(stderr, "kernel_launch: hipFuncSetAttribute failed\n"); grid = -1; return; }
        (void)hipOccupancyMaxActiveBlocksPerMultiprocessor(&per_cu, (const void*)fwd_kernel, NTHR, LDS_BYTES);
        (void)hipGetLastError();
        if (per_cu < 1) per_cu = 1;
        grid = cus;
    }
    if (grid < 0) return;
    Args a{};
    a.x = (const float*)d_in[0]; a.g_pre_mix = (const float*)d_in[1]; a.w_in = (const float*)d_in[2]; a.b_gate = (const float*)d_in[3];
    a.lq1 = (const float*)d_in[4]; a.lk1 = (const float*)d_in[5]; a.lq2 = (const float*)d_in[6]; a.lk2 = (const float*)d_in[7]; a.subln = (const float*)d_in[8];
    a.w_attn = (const float*)d_in[9]; a.pool_w = (const float*)d_in[10]; a.pool_scale = (const float*)d_in[11]; a.w_poolb = (const float*)d_in[12]; a.w_out = (const float*)d_in[13];
    a.g_post_mix = (const float*)d_in[14]; a.g_pre_ffn = (const float*)d_in[15]; a.w_up = (const float*)d_in[16]; a.conv_w = (const float*)d_in[17]; a.conv_b = (const float*)d_in[18];
    a.w_down = (const float*)d_in[19]; a.g_post_ffn = (const float*)d_in[20];
    a.out = (float*)d_out; a.ws = (unsigned char*)d_ws;
    if (hipMemsetAsync((char*)d_ws + WS_CTL, 0, 16384, stream) != hipSuccess) { fprintf(stderr, "kernel_launch: memset of the barrier words failed\n"); return; }
    void* args[] = {&a};
    hipError_t e = hipLaunchCooperativeKernel((const void*)fwd_kernel, dim3(grid), dim3(NTHR), args, LDS_BYTES, stream);
    if (e != hipSuccess) fprintf(stderr, "cooperative launch failed: %s (grid %d)\n", hipGetErrorString(e), grid);
}
```

```cpp
#include <hip/hip_runtime.h>
#include <hip/hip_cooperative_groups.h>
#include <cstdio>
#include <cstdint>
namespace cg = cooperative_groups;

#define LAS __attribute__((address_space(3)))
typedef unsigned short bf16_t;
typedef short bf16x8 __attribute__((ext_vector_type(8)));
typedef float f32x4 __attribute__((ext_vector_type(4)));
typedef float f32x16 __attribute__((ext_vector_type(16)));
typedef unsigned u32x4 __attribute__((ext_vector_type(4)));
typedef unsigned u32x2 __attribute__((ext_vector_type(2)));

constexpr int NB = 4, SEQ = 4096, DM = 2048, M = NB * SEQ, NH = 8;
constexpr int INC = 8192, DFF = 5632, UPC = 2 * DFF;
constexpr float NORM_EPS = 1e-6f, SUBLN_EPS = 1e-5f, LAMBDA_INIT = 0.2f;
constexpr float LOG2E = 1.4426950408889634f;

constexpr size_t MiB = 1u << 20;
constexpr size_t WS_WDOWN = 0;
constexpr size_t WS_WIN = 22 * MiB;
constexpr size_t WS_WOUT = 54 * MiB;
constexpr size_t WS_WCAT = 62 * MiB;
constexpr size_t WS_WPT = 70 * MiB;
constexpr size_t WS_PWS = 74 * MiB;
constexpr size_t WS_H = 75 * MiB;
constexpr size_t WS_OPM = 75 * MiB;
constexpr size_t WS_QK = 139 * MiB;
constexpr size_t WS_MERGED = 139 * MiB;
constexpr size_t WS_VT = 203 * MiB;
constexpr size_t WS_PZ = 235 * MiB;
constexpr size_t WS_T = 203 * MiB;
constexpr size_t WS_GATES = 267 * MiB;
constexpr size_t WS_MO = 203 * MiB;
constexpr size_t WS_H2 = 385 * MiB;
constexpr size_t WS_WUP = 449 * MiB;
constexpr size_t WS_U = 22 * MiB;
constexpr size_t WS_SIDE = 198 * MiB;
constexpr size_t WS_Y = 374 * MiB;
constexpr size_t WS_CTL = 502 * MiB;
constexpr size_t WS_NEED = 503 * MiB;

typedef float f32x2_t __attribute__((ext_vector_type(2))); typedef __bf16 bf16x2_t __attribute__((ext_vector_type(2)));
__device__ __forceinline__ unsigned cvt_pk_bf16(float lo, float hi) { const f32x2_t v = {lo, hi}; const bf16x2_t b = __builtin_convertvector(v, bf16x2_t); return __builtin_bit_cast(unsigned, b); }
__device__ __forceinline__ float bf_lo(unsigned w) { return __uint_as_float(w << 16); }
__device__ __forceinline__ float bf_hi(unsigned w) { return __uint_as_float(w & 0xffff0000u); }
__device__ __forceinline__ float sigmoidf_(float x) { return __builtin_amdgcn_rcpf(1.0f + __builtin_amdgcn_exp2f(-x * LOG2E)); }
__device__ __forceinline__ float gelu_tanh(float x) { const float z = 0.7978845608028654f * (x + 0.044715f * x * x * x); return x * __builtin_amdgcn_rcpf(1.0f + __builtin_amdgcn_exp2f(-2.0f * LOG2E * z)); }

__device__ __forceinline__ int lane_id_volatile() { int l; asm volatile("v_mbcnt_lo_u32_b32 %0, -1, 0\n\tv_mbcnt_hi_u32_b32 %0, -1, %0" : "=v"(l)); return l; }
#define MY_TID(w0) (((w0) << 6) | lane_id_volatile())
namespace pg8 {
constexpr int BM = 256, BK = 64, HALF = 128, HTB = HALF * BK * 2, STAGE_BYTES = 8 * HTB, NXCD = 8, WGM = 8;
__host__ __device__ __forceinline__ int lds_byte(int r, int c) { const int st = (r >> 4) * 2 + (c >> 5), rr = r & 15, cc = c & 31, ob = rr * 64 + cc * 2; return st * 1024 + (ob ^ (((ob >> 9) & 1) << 5)); }
__host__ __device__ __forceinline__ void stage_rc(int b, int& R, int& C) { const int st = b / 1024, sb = b % 1024, swz = sb ^ (((sb >> 9) & 1) << 5); R = (st >> 1) * 16 + swz / 64; C = (st & 1) * 32 + (swz % 64) / 2; }
__host__ __device__ __forceinline__ int perm32(int rho) { const int n = rho >> 4, i = rho & 15; return 8 * (i >> 2) + 4 * n + (i & 3); }

struct Unit { int pm, pn; };
struct Gemm { const bf16_t* A; const bf16_t* Bt; int lda, ldb, K, ak2, apn; };

struct StaticOrder {
    int nM, nN, nwg, G, c;
    __device__ void init(int M_, int N_, int G_, int c_) { nM = M_ / BM; nN = N_ / BM; nwg = nM * nN; G = G_; c = c_; }
    __device__ bool next(int i, Unit& u) const {
        const long L = (long)i * G + c; if (L >= nwg) return false;
        int wgid = (int)L; { const int q = nwg / NXCD, r = nwg % NXCD, xcd = wgid % NXCD, off = wgid / NXCD; wgid = (xcd < r ? xcd * (q + 1) : r * (q + 1) + (xcd - r) * q) + off; }
        const int nig = WGM * nN, gid = wgid / nig, fm = gid * WGM, gsz = (nM - fm) < WGM ? (nM - fm) : WGM;
        u.pm = fm + ((wgid % nig) % gsz); u.pn = (wgid % nig) / gsz; return true;
    }
};

typedef f32x4 Acc[2][2][4][2];

template <class Epi>
__device__ __forceinline__ void gemm_phase(LAS unsigned char* lds, const Gemm g, const StaticOrder& S, const Epi& E, int wave0) {
    int tid_ = MY_TID(wave0); asm volatile("" : "+v"(tid_));
    const int tid = tid_, wid = __builtin_amdgcn_readfirstlane(tid >> 6), lane = tid & 63, wr = wid >> 2, wc = wid & 3, fr = lane & 15, fq = lane >> 4;
    const int K = g.K, nt = K / BK;
    unsigned voffA[2], voffB[2];
#pragma unroll
    for (int i = 0; i < 2; ++i) { int R, C; stage_rc(tid * 16 + i * 8192, R, C); const int Rb = Epi::PERM ? ((R & ~31) + perm32(R & 31)) : R;
        voffA[i] = (unsigned)(R * g.lda + C) * 2u; voffB[i] = (unsigned)(Rb * g.ldb + C) * 2u; }
    const size_t kstep = (size_t)(BK * 2);
    const size_t ak2 = (size_t)g.ak2;
    const size_t hstepA = (size_t)HALF * g.lda * 2, hstepB = (size_t)HALF * g.ldb * 2;
    const size_t tstepA = 2 * hstepA, tstepB = 2 * hstepB;
    const unsigned ldsw = (unsigned)wid * 1024u;
    const int aoff = lds_byte(wr * 64 + fr, fq * 8), boff = lds_byte(wc * 32 + fr, fq * 8);
#define PG8_SA(b, h) (((b) * 2 + (h)) * HTB)
#define PG8_SB(b, h) ((4 + (b) * 2 + (h)) * HTB)
#define PG8_STAGE(bufoff, gbase, voff) do { _Pragma("unroll") for (int _i = 0; _i < 2; ++_i) \
        __builtin_amdgcn_global_load_lds((const unsigned*)((const char*)(gbase) + (voff)[_i]), (LAS unsigned*)(lds + (bufoff) + ldsw + _i * 8192), 16, 0, 0); } while (0)
#define PG8_LDA(dst, b, h) do { _Pragma("unroll") for (int m = 0; m < 4; ++m) _Pragma("unroll") for (int k = 0; k < 2; ++k) dst[m][k] = *(const LAS bf16x8*)(lds + PG8_SA(b, h) + aoff + m * 2048 + k * 1024); } while (0)
#define PG8_LDB(dst, b, h) do { _Pragma("unroll") for (int n = 0; n < 2; ++n) _Pragma("unroll") for (int k = 0; k < 2; ++k) dst[n][k] = *(const LAS bf16x8*)(lds + PG8_SB(b, h) + boff + n * 2048 + k * 1024); } while (0)
#define PG8_MMA(ai, bj, At, Bt) do { __builtin_amdgcn_s_setprio(1); _Pragma("unroll") for (int m = 0; m < 4; ++m) _Pragma("unroll") for (int n = 0; n < 2; ++n) _Pragma("unroll") for (int k = 0; k < 2; ++k) \
        acc[ai][bj][m][n] = __builtin_amdgcn_mfma_f32_16x16x32_bf16(Bt[n][k], At[m][k], acc[ai][bj][m][n], 0, 0, 0); __builtin_amdgcn_s_setprio(0); } while (0)
#define PG8_WAIT_V(n) asm volatile("s_waitcnt vmcnt(" #n ")" ::: "memory")
#define PG8_WAIT_L(n) asm volatile("s_waitcnt lgkmcnt(" #n ")" ::: "memory")
#define PG8_BAR __builtin_amdgcn_s_barrier()
#define PG8_SCHED __builtin_amdgcn_sched_barrier(0)
    Unit cur, nxt; int ui = 0;
    if (!S.next(0, cur)) return;
    Acc acc;
#pragma unroll
    for (int a = 0; a < 2; ++a)
#pragma unroll
        for (int b = 0; b < 2; ++b)
#pragma unroll
            for (int m = 0; m < 4; ++m)
#pragma unroll
                for (int n = 0; n < 2; ++n) acc[a][b][m][n] = (f32x4){0.f, 0.f, 0.f, 0.f};
    bf16x8 At[4][2], B0[2][2], B1[2][2];
    const char* cA = (const char*)g.A + (size_t)cur.pm * tstepA + (size_t)cur.pn * g.apn; const char* cB = (const char*)g.Bt + (size_t)cur.pn * tstepB;
    PG8_STAGE(PG8_SB(0, 0), cB, voffB); PG8_STAGE(PG8_SB(0, 1), cB + hstepB, voffB); PG8_STAGE(PG8_SA(0, 0), cA, voffA); PG8_STAGE(PG8_SA(0, 1), cA + hstepA, voffA);
    if (wr == 1) PG8_BAR;
    PG8_WAIT_V(2); PG8_BAR;
    PG8_STAGE(PG8_SB(1, 0), cB + kstep, voffB); PG8_STAGE(PG8_SA(1, 0), cA + kstep, voffA); PG8_STAGE(PG8_SB(1, 1), cB + hstepB + kstep, voffB);
    PG8_WAIT_V(6); PG8_BAR;
    for (;;) {
        const bool has_next = S.next(ui + 1, nxt);
        const char* nA = has_next ? (const char*)g.A + (size_t)nxt.pm * tstepA + (size_t)nxt.pn * g.apn : cA; const char* nB = has_next ? (const char*)g.Bt + (size_t)nxt.pn * tstepB : cB;
        const int nhalf_ = Epi::MID ? 2 : 1, tspan_ = nt / nhalf_;
#pragma unroll 1
        for (int hk = 0; hk < nhalf_; ++hk) {
        if constexpr (Epi::MID) { if (hk == 1) E.mid(acc, cur, wr, wc, fr, fq); }
#pragma unroll 1
        for (int t = hk * tspan_; t < (hk + 1) * tspan_; t += 2) {
            const bool last = (t == nt - 2);
            const char* aT = cA + (size_t)(t >> 1) * ak2;
            const char* a1 = aT + kstep;
            const char* a2 = last ? nA : aT + ak2; const char* b2 = last ? nB : cB + (size_t)(t + 2) * kstep;
            const char* a3 = a2 + kstep; const char* b3 = b2 + kstep;
            PG8_LDB(B0, 0, 0); PG8_LDB(B1, 0, 1); PG8_SCHED; PG8_LDA(At, 0, 0); PG8_STAGE(PG8_SA(1, 1), a1 + hstepA, voffA);
            PG8_WAIT_V(8); PG8_WAIT_L(0); PG8_BAR; PG8_MMA(0, 0, At, B0); PG8_MMA(0, 1, At, B1); PG8_BAR; PG8_SCHED;
            PG8_LDA(At, 0, 1); PG8_STAGE(PG8_SB(0, 0), b2, voffB); PG8_STAGE(PG8_SB(0, 1), b2 + hstepB, voffB); PG8_STAGE(PG8_SA(0, 0), a2, voffA);
            PG8_WAIT_V(8); PG8_WAIT_L(0); PG8_BAR; PG8_MMA(1, 0, At, B0); PG8_MMA(1, 1, At, B1); PG8_BAR; PG8_SCHED;
            PG8_LDB(B0, 1, 0); PG8_LDB(B1, 1, 1); PG8_SCHED; PG8_LDA(At, 1, 0); PG8_STAGE(PG8_SA(0, 1), a2 + hstepA, voffA);
            PG8_WAIT_V(8); PG8_WAIT_L(0); PG8_BAR; PG8_MMA(0, 0, At, B0); PG8_MMA(0, 1, At, B1); PG8_BAR; PG8_SCHED;
            PG8_LDA(At, 1, 1); PG8_STAGE(PG8_SB(1, 0), b3, voffB); PG8_STAGE(PG8_SB(1, 1), b3 + hstepB, voffB); PG8_STAGE(PG8_SA(1, 0), a3, voffA);
            PG8_WAIT_V(8); PG8_WAIT_L(0); PG8_BAR; PG8_MMA(1, 0, At, B0); PG8_MMA(1, 1, At, B1); PG8_BAR; PG8_SCHED;
        }
        }
        if (wr == 0) PG8_BAR;
        E(acc, cur, wr, wc, fr, fq);
        if (!has_next) break;
#pragma unroll
        for (int a = 0; a < 2; ++a)
#pragma unroll
            for (int b = 0; b < 2; ++b)
#pragma unroll
                for (int m = 0; m < 4; ++m)
#pragma unroll
                    for (int n = 0; n < 2; ++n) acc[a][b][m][n] = (f32x4){0.f, 0.f, 0.f, 0.f};
        cur = nxt; cA = nA; cB = nB; ++ui;
        if (wr == 1) PG8_BAR;
    }
    PG8_WAIT_V(0);
    PG8_BAR;
#undef PG8_SA
#undef PG8_SB
#undef PG8_STAGE
#undef PG8_LDA
#undef PG8_LDB
#undef PG8_MMA
#undef PG8_WAIT_V
#undef PG8_WAIT_L
#undef PG8_BAR
#undef PG8_SCHED
}

__device__ __forceinline__ u32x4 pack8(f32x4 v0, f32x4 v1) { u32x4 w; w.x = cvt_pk_bf16(v0[0], v0[1]); w.y = cvt_pk_bf16(v0[2], v0[3]); w.z = cvt_pk_bf16(v1[0], v1[1]); w.w = cvt_pk_bf16(v1[2], v1[3]); return w; }

template <bool SIDE> struct EpiBf16 {
    static constexpr bool PERM = true; static constexpr bool MID = false;
    bf16_t* O; int ldc; bf16_t* side;
    __device__ __forceinline__ void operator()(const Acc& acc, const Unit& u, int wr, int wc, int fr, int fq) const {
        const int row0 = u.pm * BM + wr * 64 + fr, col0 = u.pn * BM + wc * 32 + 8 * fq;
#pragma unroll
        for (int ai = 0; ai < 2; ++ai)
#pragma unroll
            for (int m = 0; m < 4; ++m) { const int row = row0 + ai * HALF + m * 16; bf16_t* rowp = O + (size_t)row * ldc + col0;
#pragma unroll
                for (int bj = 0; bj < 2; ++bj) { const u32x4 w = pack8(acc[ai][bj][m][0], acc[ai][bj][m][1]); *(u32x4*)(rowp + bj * HALF) = w;
                    if (SIDE && bj == 0) { const bool top = (fr == 0) && ((m & 1) == 0), bot = (fr == 15) && ((m & 1) == 1);
                        if (top || bot) *(u32x4*)(side + (size_t)((row >> 5) * 2 + (bot ? 1 : 0)) * DFF + u.pn * HALF + wc * 32 + 8 * fq) = w; } } }
    }
};
struct EpiF32 {
    static constexpr bool PERM = false; static constexpr bool MID = false;
    float* O; int ldc;
    __device__ __forceinline__ void operator()(const Acc& acc, const Unit& u, int wr, int wc, int fr, int fq) const {
        const int row0 = u.pm * BM + wr * 64 + fr, col0 = u.pn * BM + wc * 32 + 4 * fq;
#pragma unroll
        for (int ai = 0; ai < 2; ++ai)
#pragma unroll
            for (int m = 0; m < 4; ++m) { float* rowp = O + (size_t)(row0 + ai * HALF + m * 16) * ldc + col0;
#pragma unroll
                for (int bj = 0; bj < 2; ++bj)
#pragma unroll
                    for (int n = 0; n < 2; ++n) *(f32x4*)(rowp + bj * HALF + n * 16) = acc[ai][bj][m][n]; }
    }
};
template <int MODE> struct EpiGate {
    static constexpr bool PERM = true; static constexpr bool MID = false;
    const bf16_t* gates; bf16_t* T; bf16_t* OUT;
    __device__ __forceinline__ void operator()(const Acc& acc, const Unit& u, int wr, int wc, int fr, int fq) const {
        const int row0 = u.pm * BM + wr * 64 + fr, col0 = u.pn * BM + wc * 32 + 8 * fq;
#pragma unroll
        for (int ai = 0; ai < 2; ++ai)
#pragma unroll
            for (int m = 0; m < 4; ++m) { const size_t row = (size_t)(row0 + ai * HALF + m * 16);
#pragma unroll
                for (int bj = 0; bj < 2; ++bj) { const int col = col0 + bj * HALF;
                    const u32x4 gw = *(const u32x4*)(gates + row * 4096 + MODE * 2048 + col);
                    f32x4 v0 = acc[ai][bj][m][0], v1 = acc[ai][bj][m][1];
                    v0[0] *= bf_lo(gw.x); v0[1] *= bf_hi(gw.x); v0[2] *= bf_lo(gw.y); v0[3] *= bf_hi(gw.y);
                    v1[0] *= bf_lo(gw.z); v1[1] *= bf_hi(gw.z); v1[2] *= bf_lo(gw.w); v1[3] *= bf_hi(gw.w);
                    if (MODE == 1) { const u32x4 tw = *(const u32x4*)(T + row * DM + col);
                        v0[0] += bf_lo(tw.x); v0[1] += bf_hi(tw.x); v0[2] += bf_lo(tw.y); v0[3] += bf_hi(tw.y);
                        v1[0] += bf_lo(tw.z); v1[1] += bf_hi(tw.z); v1[2] += bf_lo(tw.w); v1[3] += bf_hi(tw.w);
                        *(u32x4*)(OUT + row * DM + col) = pack8(v0, v1);
                    } else *(u32x4*)(T + row * DM + col) = pack8(v0, v1); }
                asm volatile("" ::: "memory"); }
    }
};
struct EpiConv {
    static constexpr bool PERM = true; static constexpr bool MID = false;
    bf16_t* A; bf16_t* side; const float* cw; const float* cb; LAS unsigned char* scr;
    static __device__ __forceinline__ float ror1(float v) { return __int_as_float(__builtin_amdgcn_update_dpp(0, __float_as_int(v), 0x121, 0xF, 0xF, true)); }
    static __device__ __forceinline__ float ror15(float v) { return __int_as_float(__builtin_amdgcn_update_dpp(0, __float_as_int(v), 0x12F, 0xF, 0xF, true)); }
    static __device__ __forceinline__ float shr1_keep(float old, float v) { return __int_as_float(__builtin_amdgcn_update_dpp(__float_as_int(old), __float_as_int(v), 0x111, 0xF, 0xF, false)); }
    static __device__ __forceinline__ float shl1_keep(float old, float v) { return __int_as_float(__builtin_amdgcn_update_dpp(__float_as_int(old), __float_as_int(v), 0x101, 0xF, 0xF, false)); }
    __device__ __forceinline__ void operator()(const Acc& acc, const Unit& u, int wr, int wc, int fr_in, int fq_in) const {
        (void)fr_in; (void)fq_in; const int l_ = lane_id_volatile(); const int fr = l_ & 15, fq = l_ >> 4;
        int ch0 = u.pn * HALF + wc * 32 + 8 * fq, row0 = u.pm * BM + wr * 64 + fr;
        asm volatile("" : "+v"(ch0), "+v"(row0));
        const bool f0 = (fr == 0), f15 = (fr == 15);
#pragma unroll
        for (int n = 0; n < 2; ++n) {
            const int ch = ch0 + 4 * n;
            const f32x4 tg0 = *(const f32x4*)(cw + ch), tg1 = *(const f32x4*)(cw + UPC + ch), tg2 = *(const f32x4*)(cw + 2 * UPC + ch), tbg = *(const f32x4*)(cb + ch);
            const f32x4 tv0 = *(const f32x4*)(cw + DFF + ch), tv1 = *(const f32x4*)(cw + UPC + DFF + ch), tv2 = *(const f32x4*)(cw + 2 * UPC + DFF + ch), tbv = *(const f32x4*)(cb + DFF + ch);
#pragma unroll
            for (int ai = 0; ai < 2; ++ai) {
                LAS unsigned* mys = (LAS unsigned*)(scr + (wr * 4 + wc) * 2048 + l_ * 32);
                float even_[4];
#pragma unroll
                for (int j = 0; j < 4; ++j) {
                    const float wg0 = tg0[j], wg1 = tg1[j], wg2 = tg2[j], bg = tbg[j];
                    const float wv0 = tv0[j], wv1 = tv1[j], wv2 = tv2[j], bv = tbv[j];
                    float keep[4];
                    { float p1[4], p5[4];
#pragma unroll
                      for (int m = 0; m < 4; ++m) { p1[m] = ror1(acc[ai][0][m][n][j]); p5[m] = ror15(acc[ai][0][m][n][j]); }
#pragma unroll
                      for (int m = 0; m < 4; ++m) { const int mp = m > 0 ? m - 1 : 0, mn = m < 3 ? m + 1 : 3;
                          keep[m] = wg0 * (f0 ? p1[mp] : p1[m]) + wg1 * acc[ai][0][m][n][j] + wg2 * (f15 ? p5[mn] : p5[m]) + bg; } }
                    __builtin_amdgcn_sched_barrier(0);
                    { float p1[4], p5[4];
#pragma unroll
                      for (int m = 0; m < 4; ++m) { p1[m] = ror1(acc[ai][1][m][n][j]); p5[m] = ror15(acc[ai][1][m][n][j]); }
#pragma unroll
                      for (int m = 0; m < 4; ++m) { const int mp = m > 0 ? m - 1 : 0, mn = m < 3 ? m + 1 : 3;
                          const float v = wv0 * (f0 ? p1[mp] : p1[m]) + wv1 * acc[ai][1][m][n][j] + wv2 * (f15 ? p5[mn] : p5[m]) + bv;
                          keep[m] = gelu_tanh(keep[m]) * v; } }
                    __builtin_amdgcn_sched_barrier(0);
#pragma unroll
                    for (int m = 0; m < 4; ++m) { if ((j & 1) == 0) even_[m] = keep[m]; else mys[m * 2 + (j >> 1)] = cvt_pk_bf16(even_[m], keep[m]); }
                    __builtin_amdgcn_sched_barrier(0);
                }
#pragma unroll
                for (int m = 0; m < 4; ++m) { const int row = row0 + ai * HALF + m * 16;
                    const bool edge = (m == 0 && f0) || (m == 3 && f15);
                    const u32x2 w = *(const LAS u32x2*)(mys + m * 2);
                    if (!edge) *(u32x2*)(A + (size_t)row * DFF + ch) = w;
                    const int idx = (m == 0) ? fr : fr - 12;
                    if ((m == 0 && fr < 2) || (m == 3 && fr >= 14)) { bf16_t* sp = side + ((size_t)(row >> 6) * 4 + idx) * UPC + ch;
                        u32x2 rg, rv; rg.x = cvt_pk_bf16(acc[ai][0][m][n][0], acc[ai][0][m][n][1]); rg.y = cvt_pk_bf16(acc[ai][0][m][n][2], acc[ai][0][m][n][3]);
                        rv.x = cvt_pk_bf16(acc[ai][1][m][n][0], acc[ai][1][m][n][1]); rv.y = cvt_pk_bf16(acc[ai][1][m][n][2], acc[ai][1][m][n][3]);
                        *(u32x2*)sp = rg; *(u32x2*)(sp + DFF) = rv; } }
                asm volatile("" ::: "memory"); __builtin_amdgcn_sched_barrier(0);
            }
        }
    }
};
struct EpiGateMid {
    static constexpr bool PERM = true; static constexpr bool MID = true;
    const bf16_t* gates; bf16_t* OUT;
    __device__ __forceinline__ void mid(Acc& acc, const Unit& u, int wr, int wc, int fr, int fq) const {
        int row0 = u.pm * BM + wr * 64 + fr, col0 = u.pn * BM + wc * 32 + 8 * fq;
        asm volatile("" : "+v"(row0), "+v"(col0));
#pragma unroll
        for (int ai = 0; ai < 2; ++ai) {
#pragma unroll
            for (int m = 0; m < 4; ++m) { const size_t row = (size_t)(row0 + ai * HALF + m * 16);
#pragma unroll
                for (int bj = 0; bj < 2; ++bj) { const int col = col0 + bj * HALF;
                    const u32x4 g0 = *(const u32x4*)(gates + row * 4096 + col), g1 = *(const u32x4*)(gates + row * 4096 + 2048 + col);
                    const unsigned a0[4] = {g0.x, g0.y, g0.z, g0.w}, a1[4] = {g1.x, g1.y, g1.z, g1.w};
#pragma unroll
                    for (int q = 0; q < 4; ++q) { const float r0 = bf_lo(a0[q]) * __builtin_amdgcn_rcpf(fmaxf(bf_lo(a1[q]), 1e-6f)), r1 = bf_hi(a0[q]) * __builtin_amdgcn_rcpf(fmaxf(bf_hi(a1[q]), 1e-6f));
                        acc[ai][bj][m][q >> 1][2 * (q & 1)] *= r0; acc[ai][bj][m][q >> 1][2 * (q & 1) + 1] *= r1; } }
                if (m & 1) { asm volatile("" ::: "memory"); __builtin_amdgcn_sched_barrier(0); } } }
    }
    __device__ __forceinline__ void operator()(const Acc& acc, const Unit& u, int wr, int wc, int fr, int fq) const {
        const int row0 = u.pm * BM + wr * 64 + fr, col0 = u.pn * BM + wc * 32 + 8 * fq;
#pragma unroll
        for (int ai = 0; ai < 2; ++ai)
#pragma unroll
            for (int m = 0; m < 4; ++m) { const size_t row = (size_t)(row0 + ai * HALF + m * 16);
#pragma unroll
                for (int bj = 0; bj < 2; ++bj) { const int col = col0 + bj * HALF;
                    const u32x4 gw = *(const u32x4*)(gates + row * 4096 + 2048 + col);
                    f32x4 v0 = acc[ai][bj][m][0], v1 = acc[ai][bj][m][1];
                    v0[0] *= fmaxf(bf_lo(gw.x), 1e-6f); v0[1] *= fmaxf(bf_hi(gw.x), 1e-6f); v0[2] *= fmaxf(bf_lo(gw.y), 1e-6f); v0[3] *= fmaxf(bf_hi(gw.y), 1e-6f);
                    v1[0] *= fmaxf(bf_lo(gw.z), 1e-6f); v1[1] *= fmaxf(bf_hi(gw.z), 1e-6f); v1[2] *= fmaxf(bf_lo(gw.w), 1e-6f); v1[3] *= fmaxf(bf_hi(gw.w), 1e-6f);
                    *(u32x4*)(OUT + row * DM + col) = pack8(v0, v1); }
                asm volatile("" ::: "memory"); }
    }
};
struct EpiZ {
    static constexpr bool PERM = true; static constexpr bool MID = false;
    bf16_t* qk; bf16_t* vt; bf16_t* pz; bf16_t* gates; const float* bgate; float qscale;
    __device__ __forceinline__ void operator()(const Acc& acc, const Unit& u, int wr, int wc, int fr, int fq) const {
        const int row0 = u.pm * BM + wr * 64 + fr, cl = wc * 32 + 8 * fq;
        if (u.pn < 8) {
            const float sc = (u.pn < 4) ? qscale : 1.0f;
#pragma unroll
            for (int ai = 0; ai < 2; ++ai)
#pragma unroll
                for (int m = 0; m < 4; ++m) { bf16_t* rowp = qk + (size_t)(row0 + ai * HALF + m * 16) * 2048 + u.pn * BM + cl;
#pragma unroll
                    for (int bj = 0; bj < 2; ++bj) *(u32x4*)(rowp + bj * HALF) = pack8(acc[ai][bj][m][0] * sc, acc[ai][bj][m][1] * sc); }
        } else if (u.pn < 12) {
            const int b = u.pm >> 4, s0 = (u.pm & 15) * BM + wr * 64 + fr;
#pragma unroll
            for (int bj = 0; bj < 2; ++bj) { const int h = 2 * (u.pn - 8) + bj;
#pragma unroll
                for (int n = 0; n < 2; ++n)
#pragma unroll
                    for (int j = 0; j < 4; ++j) { bf16_t* base = vt + ((size_t)((b * NH + h) * 128 + cl + 4 * n + j)) * SEQ + s0;
#pragma unroll
                        for (int ai = 0; ai < 2; ++ai)
#pragma unroll
                            for (int m = 0; m < 4; ++m) base[ai * HALF + m * 16] = (bf16_t)(cvt_pk_bf16(acc[ai][bj][m][n][j], 0.f) & 0xffffu);
                        asm volatile("" ::: "memory"); } }
        } else if (u.pn < 16) {
#pragma unroll
            for (int ai = 0; ai < 2; ++ai)
#pragma unroll
                for (int m = 0; m < 4; ++m) { bf16_t* rowp = pz + (size_t)(row0 + ai * HALF + m * 16) * 1024 + (u.pn - 12) * BM + cl;
#pragma unroll
                    for (int bj = 0; bj < 2; ++bj) *(u32x4*)(rowp + bj * HALF) = pack8(acc[ai][bj][m][0], acc[ai][bj][m][1]); }
        } else {
            const int gc = (u.pn - 16) * BM + cl;
#pragma unroll
            for (int bj = 0; bj < 2; ++bj) {
                const f32x4 b0 = *(const f32x4*)(bgate + gc + bj * HALF), b1 = *(const f32x4*)(bgate + gc + bj * HALF + 4);
#pragma unroll
                for (int ai = 0; ai < 2; ++ai)
#pragma unroll
                    for (int m = 0; m < 4; ++m) { bf16_t* rowp = gates + (size_t)(row0 + ai * HALF + m * 16) * 4096 + gc + bj * HALF;
                        f32x4 v0 = acc[ai][bj][m][0] + b0, v1 = acc[ai][bj][m][1] + b1;
#pragma unroll
                        for (int j = 0; j < 4; ++j) { v0[j] = sigmoidf_(v0[j]); v1[j] = sigmoidf_(v1[j]); }
                        *(u32x4*)rowp = pack8(v0, v1);
                        asm volatile("" ::: "memory"); __builtin_amdgcn_sched_barrier(0); } }
        }
    }
};
}

struct Args {
    const float* x; const float* g_pre_mix; const float* w_in; const float* b_gate;
    const float* lq1; const float* lk1; const float* lq2; const float* lk2; const float* subln;
    const float* w_attn; const float* pool_w; const float* pool_scale; const float* w_poolb; const float* w_out;
    const float* g_post_mix; const float* g_pre_ffn; const float* w_up; const float* conv_w; const float* conv_b;
    const float* w_down; const float* g_post_ffn;
    float* out; unsigned char* ws;
};

#ifndef PH_MASK
#define PH_MASK 0x3ff
#endif
#define PH(k) ((PH_MASK >> (k)) & 1)
constexpr int NTHR = 512, NWAVES = 8;
constexpr int LDS_BYTES = 147456 + 256;

__device__ __forceinline__ float wave_sum(float v) {
    const int l = lane_id_volatile();
#pragma unroll
    for (int o = 1; o < 64; o <<= 1) v += __int_as_float(__builtin_amdgcn_ds_bpermute((l ^ o) << 2, __float_as_int(v)));
    return v;
}

template <int MAP>
__device__ __forceinline__ void transpose_item(const float* W, int K, int N, bf16_t* WT, int ldd, LAS float* scr, int item, int lane) {
    const int nblk = N / 32, kb = item / nblk, nb = item % nblk, k0 = 64 * kb, n0 = 32 * nb;
#pragma unroll 8
    for (int i = 0; i < 32; ++i) { const int kk = 2 * i + (lane >> 5); scr[kk * 33 + (lane & 31)] = __builtin_nontemporal_load(W + (size_t)(k0 + kk) * N + n0 + (lane & 31)); }
    asm volatile("s_waitcnt lgkmcnt(0)" ::: "memory");
    int d0 = n0;
    if (MAP == 1) { const int half = n0 >= DFF ? 1 : 0, j = n0 - half * DFF; d0 = 256 * (j >> 7) + 128 * half + (j & 127); }
    const int c = lane & 7;
#pragma unroll
    for (int j = 0; j < 4; ++j) { const int n = (lane >> 3) + 8 * j; const LAS float* s = scr + (8 * c) * 33 + n;
        u32x4 o; o.x = cvt_pk_bf16(s[0 * 33], s[1 * 33]); o.y = cvt_pk_bf16(s[2 * 33], s[3 * 33]); o.z = cvt_pk_bf16(s[4 * 33], s[5 * 33]); o.w = cvt_pk_bf16(s[6 * 33], s[7 * 33]);
        *(u32x4*)(WT + (size_t)(d0 + n) * ldd + k0 + 8 * c) = o; }
    asm volatile("s_waitcnt lgkmcnt(0)" ::: "memory");
}

__device__ __forceinline__ void rms_row_bf16(const float* xrow, const float* g, bf16_t* orow, int lane) {
    f32x4 v[8]; float s = 0.f;
#pragma unroll
    for (int j = 0; j < 8; ++j) { v[j] = __builtin_nontemporal_load((const f32x4*)(xrow + 256 * j + 4 * lane)); s += (v[j][0] * v[j][0] + v[j][1] * v[j][1]) + (v[j][2] * v[j][2] + v[j][3] * v[j][3]); }
    const float rs = 1.0f / sqrtf(wave_sum(s) * (1.0f / DM) + NORM_EPS);
#pragma unroll
    for (int j = 0; j < 8; ++j) { const f32x4 gg = *(const f32x4*)(g + 256 * j + 4 * lane); const f32x4 o = v[j] * rs * gg;
        u32x2 w; w.x = cvt_pk_bf16(o[0], o[1]); w.y = cvt_pk_bf16(o[2], o[3]); *(u32x2*)(orow + 256 * j + 4 * lane) = w; }
}

constexpr int KPITCH = 144;
constexpr int KS_BYTES = 64 * KPITCH, VS_BYTES = 128 * KPITCH, ABUF = KS_BYTES + VS_BYTES;

__device__ __forceinline__ float swap_max(float v) { auto rr = __builtin_amdgcn_permlane32_swap(__float_as_uint(v), __float_as_uint(v), false, false); return fmaxf(__uint_as_float(rr[0]), __uint_as_float(rr[1])); }
__device__ __forceinline__ float swap_sum(float v) { auto rr = __builtin_amdgcn_permlane32_swap(__float_as_uint(v), __float_as_uint(v), false, false); return __uint_as_float(rr[0]) + __uint_as_float(rr[1]); }

__device__ __forceinline__ void attn_unit(LAS unsigned char* lds, const bf16_t* __restrict__ qk, const bf16_t* __restrict__ vt, bf16_t* __restrict__ opm,
                                          const float* __restrict__ subln, int b, int h, int qb, float lam, float c2, int wave0) {
    int tid_ = MY_TID(wave0); asm volatile("" : "+v"(tid_));
    const int tid = tid_, lane = tid & 63, ql = lane & 31, hi = lane >> 5; const int wid = __builtin_amdgcn_readfirstlane(tid >> 6);
    const int qpos = qb * 256 + wid * 32 + ql;
    __attribute__((address_space(1))) const float* subln_ = (__attribute__((address_space(1))) const float*)subln; asm volatile("" : "+s"(subln_));
    const size_t rowbase = (size_t)b * SEQ;
    const int kr = tid >> 3, kc = tid & 7;
    const bf16_t* vsrc0 = vt + ((size_t)((b * NH + h) * 128 + (tid >> 3))) * SEQ + kc * 8;
    const bf16_t* vsrc1 = vsrc0 + (size_t)64 * SEQ;
    const int kdst = kr * KPITCH + kc * 16, vdst0 = KS_BYTES + (tid >> 3) * KPITCH + kc * 16, vdst1 = vdst0 + 64 * KPITCH;
    const int pirow = 16 * (ql >> 4) + 8 * ((ql >> 2) & 1) + 4 * ((ql >> 3) & 1) + (ql & 3);
    const int kfo = pirow * KPITCH + hi * 16;
    const int vfo = KS_BYTES + ql * KPITCH + hi * 16;
    constexpr int RV = 3 * KS_BYTES, RO = RV + 3 * VS_BYTES;
    const int vdstr0 = (tid >> 3) * KPITCH + kc * 16, vdstr1 = vdstr0 + 64 * KPITCH, vfr = ql * KPITCH + hi * 16;
    const int qoff = RO + wid * 4096 + lane * 16;
#pragma unroll 1
    for (int c = 0; c < 2; ++c) {
        const bf16_t* qrow = qk + (rowbase + qpos) * 2048 + h * 128 + c * 64 + hi * 8;
        bf16x8 qf[4];
#pragma unroll
        for (int dd = 0; dd < 4; ++dd) qf[dd] = *(const bf16x8*)(qrow + dd * 16);
        const bf16_t* ksrc = qk + (rowbase + kr) * 2048 + 1024 + h * 128 + c * 64 + kc * 8;
        f32x16 O[4];
#pragma unroll
        for (int db = 0; db < 4; ++db)
#pragma unroll
            for (int r = 0; r < 16; ++r) O[db][r] = 0.f;
        float mrun = -1e30f, lrun = 0.f;
#pragma unroll
        for (int dd = 0; dd < 4; ++dd) *(LAS bf16x8*)(lds + qoff + dd * 1024) = qf[dd];
        u32x4 kR, vR0, vR1;
        { const u32x4 k0_ = *(const u32x4*)ksrc, v0_ = *(const u32x4*)vsrc0, v1_ = *(const u32x4*)vsrc1;
          *(LAS u32x4*)(lds + kdst) = k0_; *(LAS u32x4*)(lds + RV + vdstr0) = v0_; *(LAS u32x4*)(lds + RV + vdstr1) = v1_; }
        __builtin_amdgcn_sched_barrier(0);
        kR = *(const u32x4*)(ksrc + (size_t)64 * 2048); vR0 = *(const u32x4*)(vsrc0 + 64); vR1 = *(const u32x4*)(vsrc1 + 64);
        __syncthreads();
#define PBAR() do { asm volatile("s_waitcnt lgkmcnt(0)" ::: "memory"); __builtin_amdgcn_s_barrier(); asm volatile("" ::: "memory"); } while (0)
        const bool lag = (wid >= 4);
        if (lag) PBAR();
        f32x16 s0, s1; bf16x8 pf_[4];
#define QKT(slot) do { const int kcur_ = (slot) * KS_BYTES; \
            _Pragma("unroll") for (int r = 0; r < 16; ++r) { s0[r] = 0.f; s1[r] = 0.f; } \
            _Pragma("unroll") for (int dd = 0; dd < 4; ++dd) { \
                const bf16x8 qp_ = *(const LAS bf16x8*)(lds + qoff + dd * 1024); \
                const bf16x8 kf0_ = *(const LAS bf16x8*)(lds + kcur_ + kfo + dd * 32), kf1_ = *(const LAS bf16x8*)(lds + kcur_ + kfo + 32 * KPITCH + dd * 32); \
                __builtin_amdgcn_sched_barrier(0); \
                s0 = __builtin_amdgcn_mfma_f32_32x32x16_bf16(kf0_, qp_, s0, 0, 0, 0); s1 = __builtin_amdgcn_mfma_f32_32x32x16_bf16(kf1_, qp_, s1, 0, 0, 0); \
                __builtin_amdgcn_sched_barrier(0); } } while (0)
#define PVM(slot) do { const int vcur_ = RV + (slot) * VS_BYTES; \
            _Pragma("unroll") for (int g = 0; g < 4; ++g) { \
                bf16x8 vf_[4]; \
                _Pragma("unroll") for (int i = 0; i < 4; ++i) vf_[i] = *(const LAS bf16x8*)(lds + vcur_ + vfr + (2 * (g >> 1) + (i & 1)) * 32 * KPITCH + (2 * (g & 1) + (i >> 1)) * 32); \
                __builtin_amdgcn_sched_barrier(0); \
                _Pragma("unroll") for (int i = 0; i < 4; ++i) O[2 * (g >> 1) + (i & 1)] = __builtin_amdgcn_mfma_f32_32x32x16_bf16(vf_[i], pf_[2 * (g & 1) + (i >> 1)], O[2 * (g >> 1) + (i & 1)], 0, 0, 0); \
                __builtin_amdgcn_sched_barrier(0); } } while (0)
#define VLD(dst, g) do { _Pragma("unroll") for (int i = 0; i < 4; ++i) dst[i] = *(const LAS bf16x8*)(lds + vcur_ + vfr + (2 * ((g) >> 1) + (i & 1)) * 32 * KPITCH + (2 * ((g) & 1) + (i >> 1)) * 32); } while (0)
#define VMM(src, g) do { _Pragma("unroll") for (int i = 0; i < 4; ++i) O[2 * ((g) >> 1) + (i & 1)] = __builtin_amdgcn_mfma_f32_32x32x16_bf16(src[i], pf_[2 * ((g) & 1) + (i >> 1)], O[2 * ((g) >> 1) + (i & 1)], 0, 0, 0); } while (0)
#define KLD(kd, qd, h2) do { _Pragma("unroll") for (int d2 = 0; d2 < 2; ++d2) { const int dd = 2 * (h2) + d2; qd[d2] = *(const LAS bf16x8*)(lds + qoff + dd * 1024); \
            kd[2 * d2] = *(const LAS bf16x8*)(lds + kcur_ + kfo + dd * 32); kd[2 * d2 + 1] = *(const LAS bf16x8*)(lds + kcur_ + kfo + 32 * KPITCH + dd * 32); } } while (0)
#define KMM(kd, qd) do { _Pragma("unroll") for (int d2 = 0; d2 < 2; ++d2) { s0 = __builtin_amdgcn_mfma_f32_32x32x16_bf16(kd[2 * d2], qd[d2], s0, 0, 0, 0); s1 = __builtin_amdgcn_mfma_f32_32x32x16_bf16(kd[2 * d2 + 1], qd[d2], s1, 0, 0, 0); } } while (0)
#define SB() __builtin_amdgcn_sched_barrier(0)
#define APHASE(vslot, kslot, DOPV, DOQK) do { const int vcur_ = RV + (vslot) * VS_BYTES, kcur_ = (kslot) * KS_BYTES; \
            bf16x8 ga_[4], gb_[4], ka_[4], qa_[2], kb_[4], qb_[2]; \
            if (DOPV) { VLD(ga_, 0); VLD(gb_, 1); SB(); VMM(ga_, 0); SB(); VLD(ga_, 2); SB(); VMM(gb_, 1); SB(); VLD(gb_, 3); SB(); VMM(ga_, 2); SB(); } \
            if (DOQK) { KLD(ka_, qa_, 0); SB(); } \
            if (DOPV) { VMM(gb_, 3); SB(); } \
            if (DOQK) { KLD(kb_, qb_, 1); SB(); \
                _Pragma("unroll") for (int r = 0; r < 16; ++r) { s0[r] = 0.f; s1[r] = 0.f; } \
                KMM(ka_, qa_); SB(); KMM(kb_, qb_); SB(); } } while (0)
#define SOFTMAX(t) do { \
            const float base_ = (float)((t) * 64 + 8 * hi - qpos); \
            float mx_ = -1e30f; \
            { float x0_ = base_, x1_ = base_ + 32.0f; \
              _Pragma("unroll") for (int r = 0; r < 16; ++r) { \
                if (r == 8) { x0_ = base_ + 16.0f; x1_ = base_ + 48.0f; } \
                s0[r] = s0[r] - c2 * fabsf(x0_); s1[r] = s1[r] - c2 * fabsf(x1_); \
                mx_ = fmaxf(mx_, fmaxf(s0[r], s1[r])); x0_ += 1.0f; x1_ += 1.0f; } } \
            mx_ = swap_max(mx_); \
            __builtin_amdgcn_sched_barrier(0); \
            const float mnew_ = fmaxf(mrun, mx_); \
            if (__any(mnew_ > mrun)) { \
                const float alpha_ = __builtin_amdgcn_exp2f(mrun - mnew_); lrun *= alpha_; \
                _Pragma("unroll") for (int db = 0; db < 4; ++db) _Pragma("unroll") for (int r = 0; r < 16; ++r) O[db][r] *= alpha_; \
                mrun = mnew_; } \
            __builtin_amdgcn_sched_barrier(0); \
            float ls_ = 0.f; \
            _Pragma("unroll") for (int r = 0; r < 16; ++r) { s0[r] = __builtin_amdgcn_exp2f(s0[r] - mrun); s1[r] = __builtin_amdgcn_exp2f(s1[r] - mrun); ls_ += s0[r] + s1[r]; } \
            lrun += ls_; \
            __builtin_amdgcn_sched_barrier(0); \
            { u32x4 w_; \
              w_.x = cvt_pk_bf16(s0[0], s0[1]); w_.y = cvt_pk_bf16(s0[2], s0[3]); w_.z = cvt_pk_bf16(s0[4], s0[5]); w_.w = cvt_pk_bf16(s0[6], s0[7]); pf_[0] = __builtin_bit_cast(bf16x8, w_); \
              w_.x = cvt_pk_bf16(s0[8], s0[9]); w_.y = cvt_pk_bf16(s0[10], s0[11]); w_.z = cvt_pk_bf16(s0[12], s0[13]); w_.w = cvt_pk_bf16(s0[14], s0[15]); pf_[1] = __builtin_bit_cast(bf16x8, w_); \
              w_.x = cvt_pk_bf16(s1[0], s1[1]); w_.y = cvt_pk_bf16(s1[2], s1[3]); w_.z = cvt_pk_bf16(s1[4], s1[5]); w_.w = cvt_pk_bf16(s1[6], s1[7]); pf_[2] = __builtin_bit_cast(bf16x8, w_); \
              w_.x = cvt_pk_bf16(s1[8], s1[9]); w_.y = cvt_pk_bf16(s1[10], s1[11]); w_.z = cvt_pk_bf16(s1[12], s1[13]); w_.w = cvt_pk_bf16(s1[14], s1[15]); pf_[3] = __builtin_bit_cast(bf16x8, w_); } \
            __builtin_amdgcn_sched_barrier(0); } while (0)
#define STAGE_WRITE(slot) do { *(LAS u32x4*)(lds + (slot) * KS_BYTES + kdst) = kR; *(LAS u32x4*)(lds + RV + (slot) * VS_BYTES + vdstr0) = vR0; *(LAS u32x4*)(lds + RV + (slot) * VS_BYTES + vdstr1) = vR1; } while (0)
        APHASE(0, 0, false, true); STAGE_WRITE(1); PBAR();
        int sc = 0, sn = 1, sw = 2;
#pragma unroll 1
        for (int t = 0; t < 63; ++t) {
            if (t + 2 < 64) { kR = *(const u32x4*)(ksrc + (size_t)(t + 2) * 64 * 2048); vR0 = *(const u32x4*)(vsrc0 + (t + 2) * 64); vR1 = *(const u32x4*)(vsrc1 + (t + 2) * 64); }
            SOFTMAX(t); PBAR();
            APHASE(sc, sn, true, true);
            if (t + 2 < 64) STAGE_WRITE(sw);
            PBAR();
            { const int t_ = sc; sc = sn; sn = sw; sw = t_; }
        }
        SOFTMAX(63); PBAR();
        APHASE(sc, 0, true, false); PBAR();
        if (!lag) PBAR();
#undef STAGE_WRITE
#undef SOFTMAX
#undef PVM
#undef APHASE
#undef VLD
#undef VMM
#undef KLD
#undef KMM
#undef SB
#undef QKT
#undef PBAR
        const float inv = 1.0f / swap_sum(lrun);
        bf16_t* orow = opm + (rowbase + qpos) * 2048 + h * 128 + 4 * hi;
        if (c == 0) {
#pragma unroll
            for (int db = 0; db < 4; ++db)
#pragma unroll
                for (int g = 0; g < 4; ++g) { u32x2 w; w.x = cvt_pk_bf16(O[db][4 * g] * inv, O[db][4 * g + 1] * inv); w.y = cvt_pk_bf16(O[db][4 * g + 2] * inv, O[db][4 * g + 3] * inv);
                    *(u32x2*)(orow + 32 * db + 8 * g) = w; }
        } else {
            float ss = 0.f;
#pragma unroll
            for (int db = 0; db < 4; ++db) {
#pragma unroll
                for (int g = 0; g < 4; ++g) { const u32x2 w = *(const u32x2*)(orow + 32 * db + 8 * g); const int r = 4 * g;
                    const float a0 = bf_lo(w.x) - lam * (O[db][r] * inv), a1 = bf_hi(w.x) - lam * (O[db][r + 1] * inv), a2 = bf_lo(w.y) - lam * (O[db][r + 2] * inv), a3 = bf_hi(w.y) - lam * (O[db][r + 3] * inv);
                    O[db][r] = a0; O[db][r + 1] = a1; O[db][r + 2] = a2; O[db][r + 3] = a3; ss = fmaf(a0, a0, ss); ss = fmaf(a1, a1, ss); ss = fmaf(a2, a2, ss); ss = fmaf(a3, a3, ss);
                    asm volatile("" : "+v"(ss)); __builtin_amdgcn_sched_barrier(0); } }
            ss = swap_sum(ss);
            const float rn = (1.0f - LAMBDA_INIT) / sqrtf(ss * (1.0f / 128.0f) + SUBLN_EPS);
#pragma unroll
            for (int db = 0; db < 4; ++db)
#pragma unroll
                for (int g = 0; g < 4; ++g) { const int d = 32 * db + 8 * g;
                    const f32x4 gn = *(const f32x4*)(subln_ + d + 4 * hi);
                    u32x2 w; w.x = cvt_pk_bf16(O[db][4 * g] * rn * gn[0], O[db][4 * g + 1] * rn * gn[1]); w.y = cvt_pk_bf16(O[db][4 * g + 2] * rn * gn[2], O[db][4 * g + 3] * rn * gn[3]);
                    *(u32x2*)(orow + d) = w; }
        }
    }
}

#if defined(DBG_STOP)
__device__ __forceinline__ void dbg_dump(const Args& a, int k) {
    const size_t gt = (size_t)blockIdx.x * NTHR + threadIdx.x, NGT = (size_t)gridDim.x * NTHR;
    const bf16_t* b16 = (const bf16_t*)a.ws;
    for (size_t i = gt; i < (size_t)M * DM; i += NGT) {
        const size_t row = i / DM, col = i % DM; float v = 0.f;
        auto B = [&](size_t off, size_t idx) { return __uint_as_float((unsigned)((const bf16_t*)(a.ws + off))[idx] << 16); };
        if (k == 0) { v = B(WS_WIN, i % ((size_t)8192 * 2048)); }
        if (k == 1 && DBG_SEL == 1) { v = B(WS_GATES, row * 4096 + col) + B(WS_GATES, row * 4096 + 2048 + col); }
        if (k == 1 && DBG_SEL == 3) { v = B(WS_QK, i); }
        if (k == 1 && DBG_SEL == 4) { v = B(WS_PZ, row * 1024 + (col & 1023)) + B(WS_VT, row * 1024 + (col & 1023)); }
        if (k == 1 && DBG_SEL == 2) { v = B(WS_WCAT, i % ((size_t)2048 * 2048)); }
        if (k == 1 && DBG_SEL == 0) { v = B(WS_QK, i) + B(WS_PZ, row * 1024 + (col & 1023)) + B(WS_VT, row * 1024 + (col & 1023)) + B(WS_GATES, row * 4096 + col) + B(WS_GATES, row * 4096 + 2048 + col) + B(WS_WCAT, i % ((size_t)2048 * 2048)); }
        if (k == 2) { v = B(WS_OPM, i); }
        if (k == 3) { v = B(WS_MERGED, i) + B(WS_T, i); }
        if (k == 4) { v = ((const float*)(a.ws + WS_MO))[i]; }
        if (k == 5) { v = a.out[i] + B(WS_H2, i); }
        if (k == 6) { v = B(WS_U, row * UPC + col) + B(WS_U, row * UPC + 2048 + col) + B(WS_U, row * UPC + 4096 + col) + B(WS_U, row * UPC + 6144 + col) + B(WS_U, row * UPC + 8192 + col) + B(WS_U, row * UPC + 9216 + col) + B(WS_SIDE, i % ((size_t)1024 * 5632)); }
        if (k == 7) { v = B(WS_U, row * UPC + col) + B(WS_U, row * UPC + 2048 + col) + B(WS_U, row * UPC + 4096 + col) + B(WS_U, row * UPC + 6144 + col) + B(WS_U, row * UPC + 8192 + col) + B(WS_U, row * UPC + 9216 + col); }
        if (k == 8) { v = ((const float*)(a.ws + WS_Y))[i]; }
        a.out[i] = v;
    }
}
#endif

#define XB_TMO      128
#define XB_XCNT(j)  (256  + 64 * (j))
#define XB_XSUB(j)  (1280 + 64 * (j))
#define XB_XGEN(j)  (2304 + 64 * (j))
#define XB_TOP      3328
#define XB_TOPGEN   3392
#define XCD_BAR_WORDS 3456
#define XB_SPIN_CAP (1u << 18)
__device__ __forceinline__ unsigned xb_ld(unsigned* p)              { return __hip_atomic_load(p, __ATOMIC_RELAXED, __HIP_MEMORY_SCOPE_AGENT); }
__device__ __forceinline__ unsigned xb_add(unsigned* p, unsigned v) { return __hip_atomic_fetch_add(p, v, __ATOMIC_RELAXED, __HIP_MEMORY_SCOPE_AGENT); }
__device__ __forceinline__ unsigned xb_xcc_id() { return (unsigned)__builtin_amdgcn_s_getreg((3 << 11) | 20) & 0xFu; }
#define XB_SPIN(cond, bar) do { unsigned _sp = 0; while (cond) { __builtin_amdgcn_s_sleep(1); \
    if ((++_sp & 255u) == 0u) { if (xb_ld(&(bar)[XB_TMO])) break; if (_sp > XB_SPIN_CAP) { atomicAdd(&(bar)[XB_TMO], 1u); break; } } } } while (0)
__device__ __forceinline__ void xcd_barrier_complete(unsigned* bar, unsigned x, unsigned& nloc, unsigned& nx) {
    const unsigned G = gridDim.x * gridDim.y * gridDim.z;
    unsigned sum, cnt, mine, sp = 0u;
    for (;;) {
        sum = 0u; cnt = 0u; mine = 0u;
#pragma unroll
        for (unsigned j = 0; j < 16; ++j) { const unsigned c = xb_ld(&bar[XB_XCNT(j)]); sum += c; cnt += (c > 0u) ? 1u : 0u; mine = (j == x) ? c : mine; }
        if (sum == G) break;
        __builtin_amdgcn_s_sleep(1);
        if ((++sp & 255u) == 0u) { if (xb_ld(&bar[XB_TMO])) break; if (sp > XB_SPIN_CAP) { atomicAdd(&bar[XB_TMO], 1u); break; } }
    }
    nloc = mine > 0u ? mine : 1u; nx = cnt > 0u ? cnt : 1u;
}
__device__ __forceinline__ void xcd_barrier(unsigned* bar, unsigned x, volatile LAS unsigned* st, bool tid0) {
    asm volatile("s_waitcnt vmcnt(0)" ::: "memory");
    __syncthreads();
    if (tid0) {
        __builtin_amdgcn_s_waitcnt(0);
        unsigned nloc = st[0], nx = st[1];
        if (nloc == 0u) { xcd_barrier_complete(bar, x, nloc, nx); st[0] = nloc; st[1] = nx; }
        const unsigned old = xb_add(&bar[XB_XSUB(x)], 1u);
        const unsigned gen = old / nloc;
        if (old + 1u == (gen + 1u) * nloc) {
            __builtin_amdgcn_fence(__ATOMIC_RELEASE, "agent");
            asm volatile("s_waitcnt vmcnt(0)" ::: "memory");
            const unsigned og = xb_add(&bar[XB_TOP], 1u);
            const unsigned tg = og / nx;
            if (og + 1u == (tg + 1u) * nx) xb_add(&bar[XB_TOPGEN], 1u);
            else XB_SPIN(xb_ld(&bar[XB_TOPGEN]) == tg, bar);
            __builtin_amdgcn_fence(__ATOMIC_ACQUIRE, "agent");
            xb_add(&bar[XB_XGEN(x)], 1u);
            asm volatile("s_waitcnt vmcnt(0)" ::: "memory");
        } else {
            XB_SPIN(xb_ld(&bar[XB_XGEN(x)]) == gen, bar);
            __builtin_amdgcn_fence(__ATOMIC_ACQUIRE, "agent");
            asm volatile("s_waitcnt vmcnt(0)" ::: "memory");
        }
    }
    __syncthreads();
}

__device__ unsigned g_bar[64];
__global__ void __launch_bounds__(NTHR, 2) fwd_kernel(Args a) {
    extern __shared__ __attribute__((aligned(16))) unsigned char lds_raw[];
    LAS unsigned char* lds = (LAS unsigned char*)lds_raw;
    cg::grid_group grid = cg::this_grid();
    const int G = gridDim.x, bx = blockIdx.x;
    const int wave0 = __builtin_amdgcn_readfirstlane((int)threadIdx.x >> 6);
    const int vcu = (G % 8 == 0) ? (bx % 8) * (G / 8) + bx / 8 : bx;
    const int NGW = G * NWAVES, NGT = G * NTHR;
    unsigned* const xb_bar = (unsigned*)(a.ws + WS_CTL);
    volatile LAS unsigned* const xb_st = (volatile LAS unsigned*)(lds + LDS_BYTES - 64);
    const unsigned xb_x = xb_xcc_id();
    if (MY_TID(wave0) == 0) { xb_st[0] = 0u; xb_st[1] = 0u; (void)xb_add(&xb_bar[XB_XCNT(xb_x)], 1u); }
    __syncthreads();
    if (a.ws == nullptr) grid.sync();
#define GRID_SYNC() xcd_barrier(xb_bar, xb_x, xb_st, MY_TID(wave0) == 0)
#define PHASE_VIEW() \
    int tid_ = MY_TID(wave0); asm volatile("" : "+v"(tid_)); const int tid = tid_, lane = tid & 63, wave = wave0; \
    const int gw = vcu * NWAVES + wave, gt = bx * NTHR + tid; (void)gw; (void)gt; (void)lane; \
    __attribute__((address_space(1))) unsigned char* ws = (__attribute__((address_space(1))) unsigned char*)a.ws; asm volatile("" : "+s"(ws));     \
    bf16_t* WdownT = (bf16_t*)(ws + WS_WDOWN); bf16_t* WinT = (bf16_t*)(ws + WS_WIN); bf16_t* WoutT = (bf16_t*)(ws + WS_WOUT); \
    bf16_t* WcatT = (bf16_t*)(ws + WS_WCAT); bf16_t* WpT = (bf16_t*)(ws + WS_WPT); bf16_t* PWs = (bf16_t*)(ws + WS_PWS); \
    bf16_t* Hb = (bf16_t*)(ws + WS_H); bf16_t* OPM = (bf16_t*)(ws + WS_OPM); bf16_t* QK = (bf16_t*)(ws + WS_QK); bf16_t* MERGED = (bf16_t*)(ws + WS_MERGED); \
    bf16_t* VT = (bf16_t*)(ws + WS_VT); bf16_t* PZ = (bf16_t*)(ws + WS_PZ); bf16_t* Tb = (bf16_t*)(ws + WS_T); bf16_t* GATES = (bf16_t*)(ws + WS_GATES); \
    float* MO = (float*)(ws + WS_MO); bf16_t* H2 = (bf16_t*)(ws + WS_H2); bf16_t* WupT = (bf16_t*)(ws + WS_WUP); bf16_t* U = (bf16_t*)(ws + WS_U); \
    bf16_t* SIDE = (bf16_t*)(ws + WS_SIDE); float* Y = (float*)(ws + WS_Y); \
    (void)WdownT; (void)WinT; (void)WoutT; (void)WcatT; (void)WpT; (void)PWs; (void)Hb; (void)OPM; (void)QK; (void)MERGED; (void)VT; (void)PZ; (void)Tb; (void)GATES; (void)MO; (void)H2; (void)WupT; (void)U; (void)SIDE; (void)Y;

    if (PH(0)) { PHASE_VIEW()
        LAS float* scr = (LAS float*)(lds + wave * 16384);
        constexpr int I_IN = (DM / 64) * (INC / 32), I_UP = (DM / 64) * (UPC / 32), I_DN = (DFF / 64) * (DM / 32), I_OUT = (DM / 64) * (DM / 32), I_AT = (1024 / 64) * (DM / 32), I_PB = I_AT;
        constexpr int NITEMS = I_IN + I_UP + I_DN + I_OUT + I_AT + I_PB;
        for (int it = gw; it < NITEMS; it += NGW) {
            int r = it;
            if (r < I_IN) { transpose_item<0>(a.w_in, DM, INC, WinT, DM, scr, r, lane); continue; } r -= I_IN;
            if (r < I_UP) { transpose_item<1>(a.w_up, DM, UPC, WupT, DM, scr, r, lane); continue; } r -= I_UP;
            if (r < I_DN) { transpose_item<0>(a.w_down, DFF, DM, WdownT, DFF, scr, r, lane); continue; } r -= I_DN;
            if (r < I_OUT) { transpose_item<0>(a.w_out, DM, DM, WoutT, DM, scr, r, lane); continue; } r -= I_OUT;
            if (r < I_AT) { transpose_item<0>(a.w_attn, 1024, DM, WcatT, DM, scr, r, lane); continue; } r -= I_AT;
            transpose_item<0>(a.w_poolb, 1024, DM, WpT, 1024, scr, r, lane);
        }
        for (int i = gt; i < 1024 * 256 / 4; i += NGT) { const int e = i * 4, gcl = e >> 8, dp = e & 255, g = gcl >> 8;
            const f32x4 w = *(const f32x4*)(a.pool_w + e), sc = *(const f32x4*)(a.pool_scale + g * 256 + dp); const f32x4 o = w * sc;
            u32x2 p; p.x = cvt_pk_bf16(o[0], o[1]); p.y = cvt_pk_bf16(o[2], o[3]); *(u32x2*)(PWs + e) = p; }
        for (int m = gw; m < M; m += NGW) rms_row_bf16(a.x + (size_t)m * DM, a.g_pre_mix, Hb + (size_t)m * DM, lane);
    }
    GRID_SYNC();
#if defined(DBG_STOP)
    if (DBG_STOP == 0) { dbg_dump(a, 0); return; }
#endif

    if (PH(1)) { PHASE_VIEW()
#ifndef NO_MINI
        {
            pg8::Gemm gm{WpT, PWs, 1024, 256, 256, 256, 512};
            pg8::StaticOrder S; S.init(DM, 1024, G, bx);
            pg8::EpiBf16<false> E{WcatT + 1024, DM, nullptr};
            pg8::gemm_phase(lds, gm, S, E, wave0);
        }
#endif
#ifndef NO_Z
        pg8::Gemm gm{Hb, WinT, DM, DM, DM, 256, 0};
        pg8::StaticOrder S; S.init(M, INC, G, bx);
        pg8::EpiZ E{QK, VT, PZ, GATES, a.b_gate, 0.125f * LOG2E};
        pg8::gemm_phase(lds, gm, S, E, wave0);
#endif
    }
    GRID_SYNC();
#if defined(DBG_STOP)
    if (DBG_STOP == 1) { dbg_dump(a, 1); return; }
#endif

    if (PH(2)) { PHASE_VIEW()
        for (int i = gt; i < (M / 16) * 128; i += NGT) {
            const int vec = i & 127, rb = i >> 7, g = vec >> 5, half = 1 << g, row0 = rb * 16, s0 = row0 & (SEQ - 1);
            const bf16_t* base = PZ + (size_t)(row0 - s0) * 1024 + vec * 8;
            bf16_t* outp = OPM + (size_t)row0 * 2048 + 1024 + vec * 8;
            int lo = (s0 - half < 0) ? 0 : s0 - half, hi_ = (s0 + half > SEQ) ? SEQ : s0 + half;
            float acc[8];
#pragma unroll
            for (int j = 0; j < 8; ++j) acc[j] = 0.f;
            for (int r = lo; r < hi_; ++r) { const u32x4 w = *(const u32x4*)(base + (size_t)r * 1024);
                acc[0] += bf_lo(w.x); acc[1] += bf_hi(w.x); acc[2] += bf_lo(w.y); acc[3] += bf_hi(w.y); acc[4] += bf_lo(w.z); acc[5] += bf_hi(w.z); acc[6] += bf_lo(w.w); acc[7] += bf_hi(w.w); }
#pragma unroll 4
            for (int k = 0; k < 16; ++k) {
                const int s = s0 + k;
                const u32x4 w = *(const u32x4*)(base + (size_t)s * 1024);
                const float ic = 1.0f / (float)(hi_ - lo);
                u32x4 o;
                o.x = cvt_pk_bf16(acc[0] * ic - bf_lo(w.x), acc[1] * ic - bf_hi(w.x)); o.y = cvt_pk_bf16(acc[2] * ic - bf_lo(w.y), acc[3] * ic - bf_hi(w.y));
                o.z = cvt_pk_bf16(acc[4] * ic - bf_lo(w.z), acc[5] * ic - bf_hi(w.z)); o.w = cvt_pk_bf16(acc[6] * ic - bf_lo(w.w), acc[7] * ic - bf_hi(w.w));
                *(u32x4*)(outp + (size_t)k * 2048) = o;
                if (s - half >= 0) { const u32x4 q = *(const u32x4*)(base + (size_t)(s - half) * 1024);
                    acc[0] -= bf_lo(q.x); acc[1] -= bf_hi(q.x); acc[2] -= bf_lo(q.y); acc[3] -= bf_hi(q.y); acc[4] -= bf_lo(q.z); acc[5] -= bf_hi(q.z); acc[6] -= bf_lo(q.w); acc[7] -= bf_hi(q.w); ++lo; }
                if (s + half < SEQ) { const u32x4 q = *(const u32x4*)(base + (size_t)(s + half) * 1024);
                    acc[0] += bf_lo(q.x); acc[1] += bf_hi(q.x); acc[2] += bf_lo(q.y); acc[3] += bf_hi(q.y); acc[4] += bf_lo(q.z); acc[5] += bf_hi(q.z); acc[6] += bf_lo(q.w); acc[7] += bf_hi(q.w); ++hi_; }
            }
        }
        const float d1 = wave_sum(a.lq1[lane] * a.lk1[lane]), d2 = wave_sum(a.lq2[lane] * a.lk2[lane]);
        const float lam = expf(d1) - expf(d2) + LAMBDA_INIT;
        for (int uidx = vcu; uidx < NB * NH * 16; uidx += G) {
            const int bh = uidx >> 4, qb = uidx & 15, b = bh >> 3, h = bh & 7;
            const float c2 = exp2f(-(float)(h + 1)) * LOG2E;
            attn_unit(lds, QK, VT, OPM, a.subln, b, h, qb, lam, c2, wave0);
        }
    }
    GRID_SYNC();
#if defined(DBG_STOP)
    if (DBG_STOP == 2) { dbg_dump(a, 2); return; }
#endif

    if (PH(3)) { PHASE_VIEW()
        pg8::StaticOrder S; S.init(M, DM, G, bx);
        { pg8::Gemm gm{OPM, WcatT, DM, DM, DM, 256, 0}; pg8::EpiGateMid E{GATES, MERGED}; pg8::gemm_phase(lds, gm, S, E, wave0); }
    }
    GRID_SYNC();
#if defined(DBG_STOP)
    if (DBG_STOP == 3) { dbg_dump(a, 3); return; }
#endif

    if (PH(4)) { PHASE_VIEW()
        pg8::Gemm gm{MERGED, WoutT, DM, DM, DM, 256, 0}; pg8::StaticOrder S; S.init(M, DM, G, bx);
        pg8::EpiF32 E{MO, DM}; pg8::gemm_phase(lds, gm, S, E, wave0);
    }
    GRID_SYNC();
#if defined(DBG_STOP)
    if (DBG_STOP == 4) { dbg_dump(a, 4); return; }
#endif

    if (PH(5)) { PHASE_VIEW()
    for (int m = gw; m < M; m += NGW) {
        const float* mor = MO + (size_t)m * DM; const float* xr = a.x + (size_t)m * DM; float* o = a.out + (size_t)m * DM; bf16_t* h2r = H2 + (size_t)m * DM;
        f32x4 v[8]; float s = 0.f;
#pragma unroll
        for (int j = 0; j < 8; ++j) { v[j] = __builtin_nontemporal_load((const f32x4*)(mor + 256 * j + 4 * lane)); s += (v[j][0] * v[j][0] + v[j][1] * v[j][1]) + (v[j][2] * v[j][2] + v[j][3] * v[j][3]); }
        const float rs = 1.0f / sqrtf(wave_sum(s) * (1.0f / DM) + NORM_EPS);
        float s2 = 0.f;
#pragma unroll
        for (int j = 0; j < 8; ++j) { const f32x4 gg = *(const f32x4*)(a.g_post_mix + 256 * j + 4 * lane), xx = __builtin_nontemporal_load((const f32x4*)(xr + 256 * j + 4 * lane));
            v[j] = xx + v[j] * rs * gg; *(f32x4*)(o + 256 * j + 4 * lane) = v[j];
            s2 += (v[j][0] * v[j][0] + v[j][1] * v[j][1]) + (v[j][2] * v[j][2] + v[j][3] * v[j][3]); }
        const float rs2 = 1.0f / sqrtf(wave_sum(s2) * (1.0f / DM) + NORM_EPS);
#pragma unroll
        for (int j = 0; j < 8; ++j) { const f32x4 gg = *(const f32x4*)(a.g_pre_ffn + 256 * j + 4 * lane); const f32x4 q = v[j] * rs2 * gg;
            u32x2 w; w.x = cvt_pk_bf16(q[0], q[1]); w.y = cvt_pk_bf16(q[2], q[3]); *(u32x2*)(h2r + 256 * j + 4 * lane) = w; }
    } }
    GRID_SYNC();
#if defined(DBG_STOP)
    if (DBG_STOP == 5) { dbg_dump(a, 5); return; }
#endif

    if (PH(6)) { PHASE_VIEW()
        pg8::Gemm gm{H2, WupT, DM, DM, DM, 256, 0}; pg8::StaticOrder S; S.init(M, UPC, G, bx);
        pg8::EpiConv E{U, SIDE, a.conv_w, a.conv_b, lds + pg8::STAGE_BYTES}; pg8::gemm_phase(lds, gm, S, E, wave0);
    }
    GRID_SYNC();
#if defined(DBG_STOP)
    if (DBG_STOP == 6) { dbg_dump(a, 6); return; }
#endif

    if (PH(7)) { PHASE_VIEW()
    for (int it = gt; it < 256 * 2 * 704; it += NGT) {
        const int v8 = it % 704, which = (it / 704) & 1, k = it / 1408, ch = 8 * v8;
        const int r = which ? 64 * k + 63 : 64 * k;
        const bool seq_first = (r & (SEQ - 1)) == 0, seq_last = ((r + 1) & (SEQ - 1)) == 0;
        const bf16_t* sk = SIDE + (size_t)k * 4 * UPC + ch;
        const bf16_t* pp = which ? sk + 2 * UPC : (seq_first ? sk : sk - UPC);
        const bf16_t* pc = which ? sk + 3 * UPC : sk;
        const bf16_t* pn = which ? (seq_last ? sk : sk + 4 * UPC) : sk + UPC;
        const bool zp = (!which) && seq_first, zn = which && seq_last;
        const u32x4 z4 = {0u, 0u, 0u, 0u};
        u32x4 gp = *(const u32x4*)pp, gc = *(const u32x4*)pc, gn = *(const u32x4*)pn, vp = *(const u32x4*)(pp + DFF), vc = *(const u32x4*)(pc + DFF), vn = *(const u32x4*)(pn + DFF);
        if (zp) { gp = z4; vp = z4; } if (zn) { gn = z4; vn = z4; }
        const unsigned gpw[4] = {gp.x, gp.y, gp.z, gp.w}, gcw[4] = {gc.x, gc.y, gc.z, gc.w}, gnw[4] = {gn.x, gn.y, gn.z, gn.w};
        const unsigned vpw[4] = {vp.x, vp.y, vp.z, vp.w}, vcw[4] = {vc.x, vc.y, vc.z, vc.w}, vnw[4] = {vn.x, vn.y, vn.z, vn.w};
        float tg[3][8], tv[3][8], tb[2][8];
#pragma unroll
        for (int k3 = 0; k3 < 3; ++k3)
#pragma unroll
            for (int hq = 0; hq < 2; ++hq) { const f32x4 x = *(const f32x4*)(a.conv_w + (size_t)k3 * UPC + ch + 4 * hq), y = *(const f32x4*)(a.conv_w + (size_t)k3 * UPC + DFF + ch + 4 * hq);
#pragma unroll
                for (int e = 0; e < 4; ++e) { tg[k3][4 * hq + e] = x[e]; tv[k3][4 * hq + e] = y[e]; } }
#pragma unroll
        for (int hq = 0; hq < 2; ++hq) { const f32x4 x = *(const f32x4*)(a.conv_b + ch + 4 * hq), y = *(const f32x4*)(a.conv_b + DFF + ch + 4 * hq);
#pragma unroll
            for (int e = 0; e < 4; ++e) { tb[0][4 * hq + e] = x[e]; tb[1][4 * hq + e] = y[e]; } }
        unsigned ow[4];
#pragma unroll
        for (int q = 0; q < 4; ++q) {
            const int e0 = 2 * q, e1 = e0 + 1;
            const float g0 = tg[0][e0] * bf_lo(gpw[q]) + tg[1][e0] * bf_lo(gcw[q]) + tg[2][e0] * bf_lo(gnw[q]) + tb[0][e0];
            const float g1 = tg[0][e1] * bf_hi(gpw[q]) + tg[1][e1] * bf_hi(gcw[q]) + tg[2][e1] * bf_hi(gnw[q]) + tb[0][e1];
            const float x0 = tv[0][e0] * bf_lo(vpw[q]) + tv[1][e0] * bf_lo(vcw[q]) + tv[2][e0] * bf_lo(vnw[q]) + tb[1][e0];
            const float x1 = tv[0][e1] * bf_hi(vpw[q]) + tv[1][e1] * bf_hi(vcw[q]) + tv[2][e1] * bf_hi(vnw[q]) + tb[1][e1];
            ow[q] = cvt_pk_bf16(gelu_tanh(g0) * x0, gelu_tanh(g1) * x1);
        }
        u32x4 o; o.x = ow[0]; o.y = ow[1]; o.z = ow[2]; o.w = ow[3];
        *(u32x4*)(U + (size_t)r * DFF + ch) = o;
    } }
    GRID_SYNC();
#if defined(DBG_STOP)
    if (DBG_STOP == 7) { dbg_dump(a, 7); return; }
#endif

    if (PH(8)) { PHASE_VIEW()
        pg8::Gemm gm{U, WdownT, DFF, DFF, DFF, 256, 0}; pg8::StaticOrder S; S.init(M, DM, G, bx);
        pg8::EpiF32 E{Y, DM}; pg8::gemm_phase(lds, gm, S, E, wave0);
    }
    GRID_SYNC();
#if defined(DBG_STOP)
    if (DBG_STOP == 8) { dbg_dump(a, 8); return; }
#endif

    if (PH(9)) { PHASE_VIEW()
    for (int m = gw; m < M; m += NGW) {
        const float* yr = Y + (size_t)m * DM; float* o = a.out + (size_t)m * DM;
        f32x4 v[8]; float s = 0.f;
#pragma unroll
        for (int j = 0; j < 8; ++j) { v[j] = __builtin_nontemporal_load((const f32x4*)(yr + 256 * j + 4 * lane)); s += (v[j][0] * v[j][0] + v[j][1] * v[j][1]) + (v[j][2] * v[j][2] + v[j][3] * v[j][3]); }
        const float rs = 1.0f / sqrtf(wave_sum(s) * (1.0f / DM) + NORM_EPS);
#pragma unroll
        for (int j = 0; j < 8; ++j) { const f32x4 gg = *(const f32x4*)(a.g_post_ffn + 256 * j + 4 * lane), xx = *(const f32x4*)(o + 256 * j + 4 * lane);
            *(f32x4*)(o + 256 * j + 4 * lane) = xx + v[j] * rs * gg; }
    } }
}

extern "C" void kernel_launch(void* const* d_in, const int* in_sizes, int n_in, void* d_out, int out_size, void* d_ws, size_t ws_size, hipStream_t stream) {
    static int grid = 0;
    if (grid == 0) {
        if (n_in != 21 || in_sizes[0] != M * DM || out_size != M * DM || ws_size < WS_NEED) { fprintf(stderr, "kernel_launch: unexpected shapes / workspace (n_in %d, ws %zu)\n", n_in, ws_size); grid = -1; return; }
        int dev = 0, cus = 0, per_cu = 0;
        (void)hipGetDevice(&dev);
        (void)hipDeviceGetAttribute(&cus, hipDeviceAttributeMultiprocessorCount, dev);
        if (hipFuncSetAttribute((const void*)fwd_kernel, hipFuncAttributeMaxDynamicSharedMemorySize, LDS_BYTES) != hipSuccess) { fprintf(stderr, "kernel_launch: hipFuncSetAttribute failed\n"); grid = -1; return; }
        (void)hipOccupancyMaxActiveBlocksPerMultiprocessor(&per_cu, (const void*)fwd_kernel, NTHR, LDS_BYTES);
        (void)hipGetLastError();
        if (per_cu < 1) per_cu = 1;
        grid = cus;
    }
    if (grid < 0) return;
    Args a{};
    a.x = (const float*)d_in[0]; a.g_pre_mix = (const float*)d_in[1]; a.w_in = (const float*)d_in[2]; a.b_gate = (const float*)d_in[3];
    a.lq1 = (const float*)d_in[4]; a.lk1 = (const float*)d_in[5]; a.lq2 = (const float*)d_in[6]; a.lk2 = (const float*)d_in[7]; a.subln = (const float*)d_in[8];
    a.w_attn = (const float*)d_in[9]; a.pool_w = (const float*)d_in[10]; a.pool_scale = (const float*)d_in[11]; a.w_poolb = (const float*)d_in[12]; a.w_out = (const float*)d_in[13];
    a.g_post_mix = (const float*)d_in[14]; a.g_pre_ffn = (const float*)d_in[15]; a.w_up = (const float*)d_in[16]; a.conv_w = (const float*)d_in[17]; a.conv_b = (const float*)d_in[18];
    a.w_down = (const float*)d_in[19]; a.g_post_ffn = (const float*)d_in[20];
    a.out = (float*)d_out; a.ws = (unsigned char*)d_ws;
    if (hipMemsetAsync((char*)d_ws + WS_CTL, 0, 16384, stream) != hipSuccess) { fprintf(stderr, "kernel_launch: memset of the barrier words failed\n"); return; }
    void* args[] = {&a};
    hipError_t e = hipLaunchCooperativeKernel((const void*)fwd_kernel, dim3(grid), dim3(NTHR), args, LDS_BYTES, stream);
    if (e != hipSuccess) fprintf(stderr, "cooperative launch failed: %s (grid %d)\n", hipGetErrorString(e), grid);
}
```

```cpp
#include <hip/hip_runtime.h>
#include <hip/hip_cooperative_groups.h>
#include <cstdio>
#include <cstdint>
namespace cg = cooperative_groups;

#define LAS __attribute__((address_space(3)))
typedef unsigned short bf16_t;
typedef short bf16x8 __attribute__((ext_vector_type(8)));
typedef float f32x4 __attribute__((ext_vector_type(4)));
typedef float f32x16 __attribute__((ext_vector_type(16)));
typedef unsigned u32x4 __attribute__((ext_vector_type(4)));
typedef unsigned u32x2 __attribute__((ext_vector_type(2)));

constexpr int NB = 4, SEQ = 4096, DM = 2048, M = NB * SEQ, NH = 8;
constexpr int INC = 8192, DFF = 5632, UPC = 2 * DFF;
constexpr float NORM_EPS = 1e-6f, SUBLN_EPS = 1e-5f, LAMBDA_INIT = 0.2f;
constexpr float LOG2E = 1.4426950408889634f;

constexpr size_t MiB = 1u << 20;
constexpr size_t WS_WDOWN = 0;
constexpr size_t WS_WIN = 22 * MiB;
constexpr size_t WS_WOUT = 54 * MiB;
constexpr size_t WS_WCAT = 62 * MiB;
constexpr size_t WS_WPT = 70 * MiB;
constexpr size_t WS_PWS = 74 * MiB;
constexpr size_t WS_H = 75 * MiB;
constexpr size_t WS_OPM = 75 * MiB;
constexpr size_t WS_QK = 139 * MiB;
constexpr size_t WS_MERGED = 139 * MiB;
constexpr size_t WS_VT = 203 * MiB;
constexpr size_t WS_PZ = 235 * MiB;
constexpr size_t WS_T = 203 * MiB;
constexpr size_t WS_GATES = 267 * MiB;
constexpr size_t WS_MO = 203 * MiB;
constexpr size_t WS_H2 = 385 * MiB;
constexpr size_t WS_WUP = 449 * MiB;
constexpr size_t WS_U = 22 * MiB;
constexpr size_t WS_SIDE = 198 * MiB;
constexpr size_t WS_Y = 374 * MiB;
constexpr size_t WS_CTL = 502 * MiB;
constexpr size_t WS_NEED = 503 * MiB;

typedef float f32x2_t __attribute__((ext_vector_type(2))); typedef __bf16 bf16x2_t __attribute__((ext_vector_type(2)));
__device__ __forceinline__ unsigned cvt_pk_bf16(float lo, float hi) { const f32x2_t v = {lo, hi}; const bf16x2_t b = __builtin_convertvector(v, bf16x2_t); return __builtin_bit_cast(unsigned, b); }
__device__ __forceinline__ float bf_lo(unsigned w) { return __uint_as_float(w << 16); }
__device__ __forceinline__ float bf_hi(unsigned w) { return __uint_as_float(w & 0xffff0000u); }
__device__ __forceinline__ float sigmoidf_(float x) { return __builtin_amdgcn_rcpf(1.0f + __builtin_amdgcn_exp2f(-x * LOG2E)); }
__device__ __forceinline__ float gelu_tanh(float x) { const float z = 0.7978845608028654f * (x + 0.044715f * x * x * x); return x * __builtin_amdgcn_rcpf(1.0f + __builtin_amdgcn_exp2f(-2.0f * LOG2E * z)); }

__device__ __forceinline__ int lane_id_volatile() { int l; asm volatile("v_mbcnt_lo_u32_b32 %0, -1, 0\n\tv_mbcnt_hi_u32_b32 %0, -1, %0" : "=v"(l)); return l; }
#define MY_TID(w0) (((w0) << 6) | lane_id_volatile())
namespace pg8 {
constexpr int BM = 256, BK = 64, HALF = 128, HTB = HALF * BK * 2, STAGE_BYTES = 8 * HTB, NXCD = 8, WGM = 8;
__host__ __device__ __forceinline__ int lds_byte(int r, int c) { const int st = (r >> 4) * 2 + (c >> 5), rr = r & 15, cc = c & 31, ob = rr * 64 + cc * 2; return st * 1024 + (ob ^ (((ob >> 9) & 1) << 5)); }
__host__ __device__ __forceinline__ void stage_rc(int b, int& R, int& C) { const int st = b / 1024, sb = b % 1024, swz = sb ^ (((sb >> 9) & 1) << 5); R = (st >> 1) * 16 + swz / 64; C = (st & 1) * 32 + (swz % 64) / 2; }
__host__ __device__ __forceinline__ int perm32(int rho) { const int n = rho >> 4, i = rho & 15; return 8 * (i >> 2) + 4 * n + (i & 3); }

struct Unit { int pm, pn; };
struct Gemm { const bf16_t* A; const bf16_t* Bt; int lda, ldb, K, ak2, apn; };

struct StaticOrder {
    int nM, nN, nwg, G, c;
    __device__ void init(int M_, int N_, int G_, int c_) { nM = M_ / BM; nN = N_ / BM; nwg = nM * nN; G = G_; c = c_; }
    __device__ bool next(int i, Unit& u) const {
        const long L = (long)i * G + c; if (L >= nwg) return false;
        int wgid = (int)L; { const int q = nwg / NXCD, r = nwg % NXCD, xcd = wgid % NXCD, off = wgid / NXCD; wgid = (xcd < r ? xcd * (q + 1) : r * (q + 1) + (xcd - r) * q) + off; }
        const int nig = WGM * nN, gid = wgid / nig, fm = gid * WGM, gsz = (nM - fm) < WGM ? (nM - fm) : WGM;
        u.pm = fm + ((wgid % nig) % gsz); u.pn = (wgid % nig) / gsz; return true;
    }
};

typedef f32x4 Acc[2][2][4][2];

template <class Epi>
__device__ __forceinline__ void gemm_phase(LAS unsigned char* lds, const Gemm g, const StaticOrder& S, const Epi& E, int wave0) {
    int tid_ = MY_TID(wave0); asm volatile("" : "+v"(tid_));
    const int tid = tid_, wid = __builtin_amdgcn_readfirstlane(tid >> 6), lane = tid & 63, wr = wid >> 2, wc = wid & 3, fr = lane & 15, fq = lane >> 4;
    const int K = g.K, nt = K / BK;
    unsigned voffA[2], voffB[2];
#pragma unroll
    for (int i = 0; i < 2; ++i) { int R, C; stage_rc(tid * 16 + i * 8192, R, C); const int Rb = Epi::PERM ? ((R & ~31) + perm32(R & 31)) : R;
        voffA[i] = (unsigned)(R * g.lda + C) * 2u; voffB[i] = (unsigned)(Rb * g.ldb + C) * 2u; }
    const size_t kstep = (size_t)(BK * 2);
    const size_t ak2 = (size_t)g.ak2;
    const size_t hstepA = (size_t)HALF * g.lda * 2, hstepB = (size_t)HALF * g.ldb * 2;
    const size_t tstepA = 2 * hstepA, tstepB = 2 * hstepB;
    const unsigned ldsw = (unsigned)wid * 1024u;
    const int aoff = lds_byte(wr * 64 + fr, fq * 8), boff = lds_byte(wc * 32 + fr, fq * 8);
#define PG8_SA(b, h) (((b) * 2 + (h)) * HTB)
#define PG8_SB(b, h) ((4 + (b) * 2 + (h)) * HTB)
#define PG8_STAGE(bufoff, gbase, voff) do { _Pragma("unroll") for (int _i = 0; _i < 2; ++_i) \
        __builtin_amdgcn_global_load_lds((const unsigned*)((const char*)(gbase) + (voff)[_i]), (LAS unsigned*)(lds + (bufoff) + ldsw + _i * 8192), 16, 0, 0); } while (0)
#define PG8_LDA(dst, b, h) do { _Pragma("unroll") for (int m = 0; m < 4; ++m) _Pragma("unroll") for (int k = 0; k < 2; ++k) dst[m][k] = *(const LAS bf16x8*)(lds + PG8_SA(b, h) + aoff + m * 2048 + k * 1024); } while (0)
#define PG8_LDB(dst, b, h) do { _Pragma("unroll") for (int n = 0; n < 2; ++n) _Pragma("unroll") for (int k = 0; k < 2; ++k) dst[n][k] = *(const LAS bf16x8*)(lds + PG8_SB(b, h) + boff + n * 2048 + k * 1024); } while (0)
#define PG8_MMA(ai, bj, At, Bt) do { __builtin_amdgcn_s_setprio(1); _Pragma("unroll") for (int m = 0; m < 4; ++m) _Pragma("unroll") for (int n = 0; n < 2; ++n) _Pragma("unroll") for (int k = 0; k < 2; ++k) \
        acc[ai][bj][m][n] = __builtin_amdgcn_mfma_f32_16x16x32_bf16(Bt[n][k], At[m][k], acc[ai][bj][m][n], 0, 0, 0); __builtin_amdgcn_s_setprio(0); } while (0)
#define PG8_WAIT_V(n) asm volatile("s_waitcnt vmcnt(" #n ")" ::: "memory")
#define PG8_WAIT_L(n) asm volatile("s_waitcnt lgkmcnt(" #n ")" ::: "memory")
#define PG8_BAR __builtin_amdgcn_s_barrier()
#define PG8_SCHED __builtin_amdgcn_sched_barrier(0)
    Unit cur, nxt; int ui = 0;
    if (!S.next(0, cur)) return;
    Acc acc;
#pragma unroll
    for (int a = 0; a < 2; ++a)
#pragma unroll
        for (int b = 0; b < 2; ++b)
#pragma unroll
            for (int m = 0; m < 4; ++m)
#pragma unroll
                for (int n = 0; n < 2; ++n) acc[a][b][m][n] = (f32x4){0.f, 0.f, 0.f, 0.f};
    bf16x8 At[4][2], B0[2][2], B1[2][2];
    const char* cA = (const char*)g.A + (size_t)cur.pm * tstepA + (size_t)cur.pn * g.apn; const char* cB = (const char*)g.Bt + (size_t)cur.pn * tstepB;
    PG8_STAGE(PG8_SB(0, 0), cB, voffB); PG8_STAGE(PG8_SB(0, 1), cB + hstepB, voffB); PG8_STAGE(PG8_SA(0, 0), cA, voffA); PG8_STAGE(PG8_SA(0, 1), cA + hstepA, voffA);
    if (wr == 1) PG8_BAR;
    PG8_WAIT_V(2); PG8_BAR;
    PG8_STAGE(PG8_SB(1, 0), cB + kstep, voffB); PG8_STAGE(PG8_SA(1, 0), cA + kstep, voffA); PG8_STAGE(PG8_SB(1, 1), cB + hstepB + kstep, voffB);
    PG8_WAIT_V(6); PG8_BAR;
    for (;;) {
        const bool has_next = S.next(ui + 1, nxt);
        const char* nA = has_next ? (const char*)g.A + (size_t)nxt.pm * tstepA + (size_t)nxt.pn * g.apn : cA; const char* nB = has_next ? (const char*)g.Bt + (size_t)nxt.pn * tstepB : cB;
        const int nhalf_ = Epi::MID ? 2 : 1, tspan_ = nt / nhalf_;
#pragma unroll 1
        for (int hk = 0; hk < nhalf_; ++hk) {
        if constexpr (Epi::MID) { if (hk == 1) E.mid(acc, cur, wr, wc, fr, fq); }
#pragma unroll 1
        for (int t = hk * tspan_; t < (hk + 1) * tspan_; t += 2) {
            const bool last = (t == nt - 2);
            const char* aT = cA + (size_t)(t >> 1) * ak2;
            const char* a1 = aT + kstep;
            const char* a2 = last ? nA : aT + ak2; const char* b2 = last ? nB : cB + (size_t)(t + 2) * kstep;
            const char* a3 = a2 + kstep; const char* b3 = b2 + kstep;
            PG8_LDB(B0, 0, 0); PG8_LDB(B1, 0, 1); PG8_SCHED; PG8_LDA(At, 0, 0); PG8_STAGE(PG8_SA(1, 1), a1 + hstepA, voffA);
            PG8_WAIT_V(8); PG8_WAIT_L(0); PG8_BAR; PG8_MMA(0, 0, At, B0); PG8_MMA(0, 1, At, B1); PG8_BAR; PG8_SCHED;
            PG8_LDA(At, 0, 1); PG8_STAGE(PG8_SB(0, 0), b2, voffB); PG8_STAGE(PG8_SB(0, 1), b2 + hstepB, voffB); PG8_STAGE(PG8_SA(0, 0), a2, voffA);
            PG8_WAIT_V(8); PG8_WAIT_L(0); PG8_BAR; PG8_MMA(1, 0, At, B0); PG8_MMA(1, 1, At, B1); PG8_BAR; PG8_SCHED;
            PG8_LDB(B0, 1, 0); PG8_LDB(B1, 1, 1); PG8_SCHED; PG8_LDA(At, 1, 0); PG8_STAGE(PG8_SA(0, 1), a2 + hstepA, voffA);
            PG8_WAIT_V(8); PG8_WAIT_L(0); PG8_BAR; PG8_MMA(0, 0, At, B0); PG8_MMA(0, 1, At, B1); PG8_BAR; PG8_SCHED;
            PG8_LDA(At, 1, 1); PG8_STAGE(PG8_SB(1, 0), b3, voffB); PG8_STAGE(PG8_SB(1, 1), b3 + hstepB, voffB); PG8_STAGE(PG8_SA(1, 0), a3, voffA);
            PG8_WAIT_V(8); PG8_WAIT_L(0); PG8_BAR; PG8_MMA(1, 0, At, B0); PG8_MMA(1, 1, At, B1); PG8_BAR; PG8_SCHED;
        }
        }
        if (wr == 0) PG8_BAR;
        E(acc, cur, wr, wc, fr, fq);
        if (!has_next) break;
#pragma unroll
        for (int a = 0; a < 2; ++a)
#pragma unroll
            for (int b = 0; b < 2; ++b)
#pragma unroll
                for (int m = 0; m < 4; ++m)
#pragma unroll
                    for (int n = 0; n < 2; ++n) acc[a][b][m][n] = (f32x4){0.f, 0.f, 0.f, 0.f};
        cur = nxt; cA = nA; cB = nB; ++ui;
        if (wr == 1) PG8_BAR;
    }
    PG8_WAIT_V(0);
    PG8_BAR;
#undef PG8_SA
#undef PG8_SB
#undef PG8_STAGE
#undef PG8_LDA
#undef PG8_LDB
#undef PG8_MMA
#undef PG8_WAIT_V
#undef PG8_WAIT_L
#undef PG8_BAR
#undef PG8_SCHED
}

__device__ __forceinline__ u32x4 pack8(f32x4 v0, f32x4 v1) { u32x4 w; w.x = cvt_pk_bf16(v0[0], v0[1]); w.y = cvt_pk_bf16(v0[2], v0[3]); w.z = cvt_pk_bf16(v1[0], v1[1]); w.w = cvt_pk_bf16(v1[2], v1[3]); return w; }

template <bool SIDE> struct EpiBf16 {
    static constexpr bool PERM = true; static constexpr bool MID = false;
    bf16_t* O; int ldc; bf16_t* side;
    __device__ __forceinline__ void operator()(const Acc& acc, const Unit& u, int wr, int wc, int fr, int fq) const {
        const int row0 = u.pm * BM + wr * 64 + fr, col0 = u.pn * BM + wc * 32 + 8 * fq;
#pragma unroll
        for (int ai = 0; ai < 2; ++ai)
#pragma unroll
            for (int m = 0; m < 4; ++m) { const int row = row0 + ai * HALF + m * 16; bf16_t* rowp = O + (size_t)row * ldc + col0;
#pragma unroll
                for (int bj = 0; bj < 2; ++bj) { const u32x4 w = pack8(acc[ai][bj][m][0], acc[ai][bj][m][1]); *(u32x4*)(rowp + bj * HALF) = w;
                    if (SIDE && bj == 0) { const bool top = (fr == 0) && ((m & 1) == 0), bot = (fr == 15) && ((m & 1) == 1);
                        if (top || bot) *(u32x4*)(side + (size_t)((row >> 5) * 2 + (bot ? 1 : 0)) * DFF + u.pn * HALF + wc * 32 + 8 * fq) = w; } } }
    }
};
struct EpiF32 {
    static constexpr bool PERM = false; static constexpr bool MID = false;
    float* O; int ldc;
    __device__ __forceinline__ void operator()(const Acc& acc, const Unit& u, int wr, int wc, int fr, int fq) const {
        const int row0 = u.pm * BM + wr * 64 + fr, col0 = u.pn * BM + wc * 32 + 4 * fq;
#pragma unroll
        for (int ai = 0; ai < 2; ++ai)
#pragma unroll
            for (int m = 0; m < 4; ++m) { float* rowp = O + (size_t)(row0 + ai * HALF + m * 16) * ldc + col0;
#pragma unroll
                for (int bj = 0; bj < 2; ++bj)
#pragma unroll
                    for (int n = 0; n < 2; ++n) *(f32x4*)(rowp + bj * HALF + n * 16) = acc[ai][bj][m][n]; }
    }
};
template <int MODE> struct EpiGate {
    static constexpr bool PERM = true; static constexpr bool MID = false;
    const bf16_t* gates; bf16_t* T; bf16_t* OUT;
    __device__ __forceinline__ void operator()(const Acc& acc, const Unit& u, int wr, int wc, int fr, int fq) const {
        const int row0 = u.pm * BM + wr * 64 + fr, col0 = u.pn * BM + wc * 32 + 8 * fq;
#pragma unroll
        for (int ai = 0; ai < 2; ++ai)
#pragma unroll
            for (int m = 0; m < 4; ++m) { const size_t row = (size_t)(row0 + ai * HALF + m * 16);
#pragma unroll
                for (int bj = 0; bj < 2; ++bj) { const int col = col0 + bj * HALF;
                    const u32x4 gw = *(const u32x4*)(gates + row * 4096 + MODE * 2048 + col);
                    f32x4 v0 = acc[ai][bj][m][0], v1 = acc[ai][bj][m][1];
                    v0[0] *= bf_lo(gw.x); v0[1] *= bf_hi(gw.x); v0[2] *= bf_lo(gw.y); v0[3] *= bf_hi(gw.y);
                    v1[0] *= bf_lo(gw.z); v1[1] *= bf_hi(gw.z); v1[2] *= bf_lo(gw.w); v1[3] *= bf_hi(gw.w);
                    if (MODE == 1) { const u32x4 tw = *(const u32x4*)(T + row * DM + col);
                        v0[0] += bf_lo(tw.x); v0[1] += bf_hi(tw.x); v0[2] += bf_lo(tw.y); v0[3] += bf_hi(tw.y);
                        v1[0] += bf_lo(tw.z); v1[1] += bf_hi(tw.z); v1[2] += bf_lo(tw.w); v1[3] += bf_hi(tw.w);
                        *(u32x4*)(OUT + row * DM + col) = pack8(v0, v1);
                    } else *(u32x4*)(T + row * DM + col) = pack8(v0, v1); }
                asm volatile("" ::: "memory"); }
    }
};
struct EpiConv {
    static constexpr bool PERM = true; static constexpr bool MID = false;
    bf16_t* A; bf16_t* side; const float* cw; const float* cb; LAS unsigned char* scr;
    static __device__ __forceinline__ float ror1(float v) { return __int_as_float(__builtin_amdgcn_update_dpp(0, __float_as_int(v), 0x121, 0xF, 0xF, true)); }
    static __device__ __forceinline__ float ror15(float v) { return __int_as_float(__builtin_amdgcn_update_dpp(0, __float_as_int(v), 0x12F, 0xF, 0xF, true)); }
    static __device__ __forceinline__ float shr1_keep(float old, float v) { return __int_as_float(__builtin_amdgcn_update_dpp(__float_as_int(old), __float_as_int(v), 0x111, 0xF, 0xF, false)); }
    static __device__ __forceinline__ float shl1_keep(float old, float v) { return __int_as_float(__builtin_amdgcn_update_dpp(__float_as_int(old), __float_as_int(v), 0x101, 0xF, 0xF, false)); }
    __device__ __forceinline__ void operator()(const Acc& acc, const Unit& u, int wr, int wc, int fr_in, int fq_in) const {
        (void)fr_in; (void)fq_in; const int l_ = lane_id_volatile(); const int fr = l_ & 15, fq = l_ >> 4;
        int ch0 = u.pn * HALF + wc * 32 + 8 * fq, row0 = u.pm * BM + wr * 64 + fr;
        asm volatile("" : "+v"(ch0), "+v"(row0));
        const bool f0 = (fr == 0), f15 = (fr == 15);
#pragma unroll
        for (int n = 0; n < 2; ++n) {
            const int ch = ch0 + 4 * n;
            const f32x4 tg0 = *(const f32x4*)(cw + ch), tg1 = *(const f32x4*)(cw + UPC + ch), tg2 = *(const f32x4*)(cw + 2 * UPC + ch), tbg = *(const f32x4*)(cb + ch);
            const f32x4 tv0 = *(const f32x4*)(cw + DFF + ch), tv1 = *(const f32x4*)(cw + UPC + DFF + ch), tv2 = *(const f32x4*)(cw + 2 * UPC + DFF + ch), tbv = *(const f32x4*)(cb + DFF + ch);
#pragma unroll
            for (int ai = 0; ai < 2; ++ai) {
                LAS unsigned* mys = (LAS unsigned*)(scr + (wr * 4 + wc) * 2048 + l_ * 32);
                float even_[4]; unsigned hi2_[4];
#pragma unroll
                for (int j = 0; j < 4; ++j) {
                    const float wg0 = tg0[j], wg1 = tg1[j], wg2 = tg2[j], bg = tbg[j];
                    const float wv0 = tv0[j], wv1 = tv1[j], wv2 = tv2[j], bv = tbv[j];
                    float keep[4];
                    { float p1[4], p5[4];
#pragma unroll
                      for (int m = 0; m < 4; ++m) { p1[m] = ror1(acc[ai][0][m][n][j]); p5[m] = ror15(acc[ai][0][m][n][j]); }
#pragma unroll
                      for (int m = 0; m < 4; ++m) { const int mp = m > 0 ? m - 1 : 0, mn = m < 3 ? m + 1 : 3;
                          keep[m] = wg0 * (f0 ? p1[mp] : p1[m]) + wg1 * acc[ai][0][m][n][j] + wg2 * (f15 ? p5[mn] : p5[m]) + bg; } }
                    __builtin_amdgcn_sched_barrier(0);
                    { float p1[4], p5[4];
#pragma unroll
                      for (int m = 0; m < 4; ++m) { p1[m] = ror1(acc[ai][1][m][n][j]); p5[m] = ror15(acc[ai][1][m][n][j]); }
#pragma unroll
                      for (int m = 0; m < 4; ++m) { const int mp = m > 0 ? m - 1 : 0, mn = m < 3 ? m + 1 : 3;
                          const float v = wv0 * (f0 ? p1[mp] : p1[m]) + wv1 * acc[ai][1][m][n][j] + wv2 * (f15 ? p5[mn] : p5[m]) + bv;
                          keep[m] = gelu_tanh(keep[m]) * v; } }
                    __builtin_amdgcn_sched_barrier(0);
#pragma unroll
                    for (int m = 0; m < 4; ++m) { if ((j & 1) == 0) even_[m] = keep[m]; else if (j == 1) mys[m] = cvt_pk_bf16(even_[m], keep[m]); else hi2_[m] = cvt_pk_bf16(even_[m], keep[m]); }
                    __builtin_amdgcn_sched_barrier(0);
                }
#pragma unroll
                for (int m = 0; m < 4; ++m) { const int row = row0 + ai * HALF + m * 16;
                    const bool edge = (m == 0 && f0) || (m == 3 && f15);
                    u32x2 w; w.x = mys[m]; w.y = hi2_[m];
                    if (!edge) *(u32x2*)(A + (size_t)row * DFF + ch) = w;
                    const int idx = (m == 0) ? fr : fr - 12;
                    if ((m == 0 && fr < 2) || (m == 3 && fr >= 14)) { bf16_t* sp = side + ((size_t)(row >> 6) * 4 + idx) * UPC + ch;
                        u32x2 rg, rv; rg.x = cvt_pk_bf16(acc[ai][0][m][n][0], acc[ai][0][m][n][1]); rg.y = cvt_pk_bf16(acc[ai][0][m][n][2], acc[ai][0][m][n][3]);
                        rv.x = cvt_pk_bf16(acc[ai][1][m][n][0], acc[ai][1][m][n][1]); rv.y = cvt_pk_bf16(acc[ai][1][m][n][2], acc[ai][1][m][n][3]);
                        *(u32x2*)sp = rg; *(u32x2*)(sp + DFF) = rv; } }
                asm volatile("" ::: "memory"); __builtin_amdgcn_sched_barrier(0);
            }
        }
    }
};
struct EpiGateMid {
    static constexpr bool PERM = true; static constexpr bool MID = true;
    const bf16_t* gates; bf16_t* OUT;
    __device__ __forceinline__ void mid(Acc& acc, const Unit& u, int wr, int wc, int fr, int fq) const {
        int row0 = u.pm * BM + wr * 64 + fr, col0 = u.pn * BM + wc * 32 + 8 * fq;
        asm volatile("" : "+v"(row0), "+v"(col0));
#pragma unroll
        for (int ai = 0; ai < 2; ++ai) {
#pragma unroll
            for (int m = 0; m < 4; ++m) { const size_t row = (size_t)(row0 + ai * HALF + m * 16);
#pragma unroll
                for (int bj = 0; bj < 2; ++bj) { const int col = col0 + bj * HALF;
                    const u32x4 g0 = *(const u32x4*)(gates + row * 4096 + col), g1 = *(const u32x4*)(gates + row * 4096 + 2048 + col);
                    const unsigned a0[4] = {g0.x, g0.y, g0.z, g0.w}, a1[4] = {g1.x, g1.y, g1.z, g1.w};
#pragma unroll
                    for (int q = 0; q < 4; ++q) { const float r0 = bf_lo(a0[q]) * __builtin_amdgcn_rcpf(fmaxf(bf_lo(a1[q]), 1e-6f)), r1 = bf_hi(a0[q]) * __builtin_amdgcn_rcpf(fmaxf(bf_hi(a1[q]), 1e-6f));
                        acc[ai][bj][m][q >> 1][2 * (q & 1)] *= r0; acc[ai][bj][m][q >> 1][2 * (q & 1) + 1] *= r1; } }
                if (m & 1) { asm volatile("" ::: "memory"); __builtin_amdgcn_sched_barrier(0); } } }
    }
    __device__ __forceinline__ void operator()(const Acc& acc, const Unit& u, int wr, int wc, int fr, int fq) const {
        const int row0 = u.pm * BM + wr * 64 + fr, col0 = u.pn * BM + wc * 32 + 8 * fq;
#pragma unroll
        for (int ai = 0; ai < 2; ++ai)
#pragma unroll
            for (int m = 0; m < 4; ++m) { const size_t row = (size_t)(row0 + ai * HALF + m * 16);
#pragma unroll
                for (int bj = 0; bj < 2; ++bj) { const int col = col0 + bj * HALF;
                    const u32x4 gw = *(const u32x4*)(gates + row * 4096 + 2048 + col);
                    f32x4 v0 = acc[ai][bj][m][0], v1 = acc[ai][bj][m][1];
                    v0[0] *= fmaxf(bf_lo(gw.x), 1e-6f); v0[1] *= fmaxf(bf_hi(gw.x), 1e-6f); v0[2] *= fmaxf(bf_lo(gw.y), 1e-6f); v0[3] *= fmaxf(bf_hi(gw.y), 1e-6f);
                    v1[0] *= fmaxf(bf_lo(gw.z), 1e-6f); v1[1] *= fmaxf(bf_hi(gw.z), 1e-6f); v1[2] *= fmaxf(bf_lo(gw.w), 1e-6f); v1[3] *= fmaxf(bf_hi(gw.w), 1e-6f);
                    *(u32x4*)(OUT + row * DM + col) = pack8(v0, v1); }
                asm volatile("" ::: "memory"); }
    }
};
struct EpiZ {
    static constexpr bool PERM = true; static constexpr bool MID = false;
    bf16_t* qk; bf16_t* vt; bf16_t* pz; bf16_t* gates; const float* bgate; float qscale;
    __device__ __forceinline__ void operator()(const Acc& acc, const Unit& u, int wr, int wc, int fr, int fq) const {
        const int row0 = u.pm * BM + wr * 64 + fr, cl = wc * 32 + 8 * fq;
        if (u.pn < 8) {
            const float sc = (u.pn < 4) ? qscale : 1.0f;
#pragma unroll
            for (int ai = 0; ai < 2; ++ai)
#pragma unroll
                for (int m = 0; m < 4; ++m) { bf16_t* rowp = qk + (size_t)(row0 + ai * HALF + m * 16) * 2048 + u.pn * BM + cl;
#pragma unroll
                    for (int bj = 0; bj < 2; ++bj) *(u32x4*)(rowp + bj * HALF) = pack8(acc[ai][bj][m][0] * sc, acc[ai][bj][m][1] * sc); }
        } else if (u.pn < 12) {
            const int b = u.pm >> 4, s0 = (u.pm & 15) * BM + wr * 64 + fr;
#pragma unroll
            for (int bj = 0; bj < 2; ++bj) { const int h = 2 * (u.pn - 8) + bj;
#pragma unroll
                for (int n = 0; n < 2; ++n)
#pragma unroll
                    for (int j = 0; j < 4; ++j) { bf16_t* base = vt + ((size_t)((b * NH + h) * 128 + cl + 4 * n + j)) * SEQ + s0;
#pragma unroll
                        for (int ai = 0; ai < 2; ++ai)
#pragma unroll
                            for (int m = 0; m < 4; ++m) base[ai * HALF + m * 16] = (bf16_t)(cvt_pk_bf16(acc[ai][bj][m][n][j], 0.f) & 0xffffu);
                        asm volatile("" ::: "memory"); } }
        } else if (u.pn < 16) {
#pragma unroll
            for (int ai = 0; ai < 2; ++ai)
#pragma unroll
                for (int m = 0; m < 4; ++m) { bf16_t* rowp = pz + (size_t)(row0 + ai * HALF + m * 16) * 1024 + (u.pn - 12) * BM + cl;
#pragma unroll
                    for (int bj = 0; bj < 2; ++bj) *(u32x4*)(rowp + bj * HALF) = pack8(acc[ai][bj][m][0], acc[ai][bj][m][1]); }
        } else {
            const int gc = (u.pn - 16) * BM + cl;
#pragma unroll
            for (int bj = 0; bj < 2; ++bj) {
                const f32x4 b0 = *(const f32x4*)(bgate + gc + bj * HALF), b1 = *(const f32x4*)(bgate + gc + bj * HALF + 4);
#pragma unroll
                for (int ai = 0; ai < 2; ++ai)
#pragma unroll
                    for (int m = 0; m < 4; ++m) { bf16_t* rowp = gates + (size_t)(row0 + ai * HALF + m * 16) * 4096 + gc + bj * HALF;
                        f32x4 v0 = acc[ai][bj][m][0] + b0, v1 = acc[ai][bj][m][1] + b1;
#pragma unroll
                        for (int j = 0; j < 4; ++j) { v0[j] = sigmoidf_(v0[j]); v1[j] = sigmoidf_(v1[j]); }
                        *(u32x4*)rowp = pack8(v0, v1);
                        asm volatile("" ::: "memory"); __builtin_amdgcn_sched_barrier(0); } }
        }
    }
};
}

struct Args {
    const float* x; const float* g_pre_mix; const float* w_in; const float* b_gate;
    const float* lq1; const float* lk1; const float* lq2; const float* lk2; const float* subln;
    const float* w_attn; const float* pool_w; const float* pool_scale; const float* w_poolb; const float* w_out;
    const float* g_post_mix; const float* g_pre_ffn; const float* w_up; const float* conv_w; const float* conv_b;
    const float* w_down; const float* g_post_ffn;
    float* out; unsigned char* ws;
};

#ifndef PH_MASK
#define PH_MASK 0x3ff
#endif
#define PH(k) ((PH_MASK >> (k)) & 1)
constexpr int NTHR = 512, NWAVES = 8;
constexpr int LDS_BYTES = 147456 + 256;

__device__ __forceinline__ float wave_sum(float v) {
    const int l = lane_id_volatile();
#pragma unroll
    for (int o = 1; o < 64; o <<= 1) v += __int_as_float(__builtin_amdgcn_ds_bpermute((l ^ o) << 2, __float_as_int(v)));
    return v;
}

template <int MAP>
__device__ __forceinline__ void transpose_item(const float* W, int K, int N, bf16_t* WT, int ldd, LAS float* scr, int item, int lane) {
    const int nblk = N / 32, kb = item / nblk, nb = item % nblk, k0 = 64 * kb, n0 = 32 * nb;
#pragma unroll 8
    for (int i = 0; i < 32; ++i) { const int kk = 2 * i + (lane >> 5); scr[kk * 33 + (lane & 31)] = __builtin_nontemporal_load(W + (size_t)(k0 + kk) * N + n0 + (lane & 31)); }
    asm volatile("s_waitcnt lgkmcnt(0)" ::: "memory");
    int d0 = n0;
    if (MAP == 1) { const int half = n0 >= DFF ? 1 : 0, j = n0 - half * DFF; d0 = 256 * (j >> 7) + 128 * half + (j & 127); }
    const int c = lane & 7;
#pragma unroll
    for (int j = 0; j < 4; ++j) { const int n = (lane >> 3) + 8 * j; const LAS float* s = scr + (8 * c) * 33 + n;
        u32x4 o; o.x = cvt_pk_bf16(s[0 * 33], s[1 * 33]); o.y = cvt_pk_bf16(s[2 * 33], s[3 * 33]); o.z = cvt_pk_bf16(s[4 * 33], s[5 * 33]); o.w = cvt_pk_bf16(s[6 * 33], s[7 * 33]);
        *(u32x4*)(WT + (size_t)(d0 + n) * ldd + k0 + 8 * c) = o; }
    asm volatile("s_waitcnt lgkmcnt(0)" ::: "memory");
}

__device__ __forceinline__ void rms_row_bf16(const float* xrow, const float* g, bf16_t* orow, int lane) {
    f32x4 v[8]; float s = 0.f;
#pragma unroll
    for (int j = 0; j < 8; ++j) { v[j] = __builtin_nontemporal_load((const f32x4*)(xrow + 256 * j + 4 * lane)); s += (v[j][0] * v[j][0] + v[j][1] * v[j][1]) + (v[j][2] * v[j][2] + v[j][3] * v[j][3]); }
    const float rs = 1.0f / sqrtf(wave_sum(s) * (1.0f / DM) + NORM_EPS);
#pragma unroll
    for (int j = 0; j < 8; ++j) { const f32x4 gg = *(const f32x4*)(g + 256 * j + 4 * lane); const f32x4 o = v[j] * rs * gg;
        u32x2 w; w.x = cvt_pk_bf16(o[0], o[1]); w.y = cvt_pk_bf16(o[2], o[3]); *(u32x2*)(orow + 256 * j + 4 * lane) = w; }
}

constexpr int KPITCH = 144;
constexpr int KS_BYTES = 64 * KPITCH, VS_BYTES = 128 * KPITCH, ABUF = KS_BYTES + VS_BYTES;

__device__ __forceinline__ float swap_max(float v) { auto rr = __builtin_amdgcn_permlane32_swap(__float_as_uint(v), __float_as_uint(v), false, false); return fmaxf(__uint_as_float(rr[0]), __uint_as_float(rr[1])); }
__device__ __forceinline__ float swap_sum(float v) { auto rr = __builtin_amdgcn_permlane32_swap(__float_as_uint(v), __float_as_uint(v), false, false); return __uint_as_float(rr[0]) + __uint_as_float(rr[1]); }

__device__ __forceinline__ void attn_unit(LAS unsigned char* lds, const bf16_t* __restrict__ qk, const bf16_t* __restrict__ vt, bf16_t* __restrict__ opm,
                                          const float* __restrict__ subln, int b, int h, int qb, float lam, float c2, int wave0) {
    int tid_ = MY_TID(wave0); asm volatile("" : "+v"(tid_));
    const int tid = tid_, lane = tid & 63, ql = lane & 31, hi = lane >> 5; const int wid = __builtin_amdgcn_readfirstlane(tid >> 6);
    const int qpos = qb * 256 + wid * 32 + ql;
    __attribute__((address_space(1))) const float* subln_ = (__attribute__((address_space(1))) const float*)subln; asm volatile("" : "+s"(subln_));
    const size_t rowbase = (size_t)b * SEQ;
    const int kr = tid >> 3, kc = tid & 7;
    const bf16_t* vsrc0 = vt + ((size_t)((b * NH + h) * 128 + (tid >> 3))) * SEQ + kc * 8;
    const bf16_t* vsrc1 = vsrc0 + (size_t)64 * SEQ;
    const int kdst = kr * KPITCH + kc * 16, vdst0 = KS_BYTES + (tid >> 3) * KPITCH + kc * 16, vdst1 = vdst0 + 64 * KPITCH;
    const int pirow = 16 * (ql >> 4) + 8 * ((ql >> 2) & 1) + 4 * ((ql >> 3) & 1) + (ql & 3);
    const int kfo = pirow * KPITCH + hi * 16;
    const int vfo = KS_BYTES + ql * KPITCH + hi * 16;
    constexpr int RV = 3 * KS_BYTES, RO = RV + 3 * VS_BYTES;
    const int vdstr0 = (tid >> 3) * KPITCH + kc * 16, vdstr1 = vdstr0 + 64 * KPITCH, vfr = ql * KPITCH + hi * 16;
    const int qoff = RO + wid * 4096 + lane * 16;
#pragma unroll 1
    for (int c = 0; c < 2; ++c) {
        const bf16_t* qrow = qk + (rowbase + qpos) * 2048 + h * 128 + c * 64 + hi * 8;
        bf16x8 qf[4];
#pragma unroll
        for (int dd = 0; dd < 4; ++dd) qf[dd] = *(const bf16x8*)(qrow + dd * 16);
        const bf16_t* ksrc = qk + (rowbase + kr) * 2048 + 1024 + h * 128 + c * 64 + kc * 8;
        f32x16 O[4];
#pragma unroll
        for (int db = 0; db < 4; ++db)
#pragma unroll
            for (int r = 0; r < 16; ++r) O[db][r] = 0.f;
        float mrun = -1e30f, lrun = 0.f;
#pragma unroll
        for (int dd = 0; dd < 4; ++dd) *(LAS bf16x8*)(lds + qoff + dd * 1024) = qf[dd];
        u32x4 kR, vR0, vR1;
        { const u32x4 k0_ = *(const u32x4*)ksrc, v0_ = *(const u32x4*)vsrc0, v1_ = *(const u32x4*)vsrc1;
          *(LAS u32x4*)(lds + kdst) = k0_; *(LAS u32x4*)(lds + RV + vdstr0) = v0_; *(LAS u32x4*)(lds + RV + vdstr1) = v1_; }
        __builtin_amdgcn_sched_barrier(0);
        kR = *(const u32x4*)(ksrc + (size_t)64 * 2048); vR0 = *(const u32x4*)(vsrc0 + 64); vR1 = *(const u32x4*)(vsrc1 + 64);
        __syncthreads();
#define PBAR() do { asm volatile("s_waitcnt lgkmcnt(0)" ::: "memory"); __builtin_amdgcn_s_barrier(); asm volatile("" ::: "memory"); } while (0)
        const bool lag = (wid >= 4);
        if (lag) PBAR();
        f32x16 s0, s1; bf16x8 pf_[4];
#define QKT(slot) do { const int kcur_ = (slot) * KS_BYTES; \
            _Pragma("unroll") for (int r = 0; r < 16; ++r) { s0[r] = 0.f; s1[r] = 0.f; } \
            _Pragma("unroll") for (int dd = 0; dd < 4; ++dd) { \
                const bf16x8 qp_ = *(const LAS bf16x8*)(lds + qoff + dd * 1024); \
                const bf16x8 kf0_ = *(const LAS bf16x8*)(lds + kcur_ + kfo + dd * 32), kf1_ = *(const LAS bf16x8*)(lds + kcur_ + kfo + 32 * KPITCH + dd * 32); \
                __builtin_amdgcn_sched_barrier(0); \
                s0 = __builtin_amdgcn_mfma_f32_32x32x16_bf16(kf0_, qp_, s0, 0, 0, 0); s1 = __builtin_amdgcn_mfma_f32_32x32x16_bf16(kf1_, qp_, s1, 0, 0, 0); \
                __builtin_amdgcn_sched_barrier(0); } } while (0)
#define PVM(slot) do { const int vcur_ = RV + (slot) * VS_BYTES; \
            _Pragma("unroll") for (int g = 0; g < 4; ++g) { \
                bf16x8 vf_[4]; \
                _Pragma("unroll") for (int i = 0; i < 4; ++i) vf_[i] = *(const LAS bf16x8*)(lds + vcur_ + vfr + (2 * (g >> 1) + (i & 1)) * 32 * KPITCH + (2 * (g & 1) + (i >> 1)) * 32); \
                __builtin_amdgcn_sched_barrier(0); \
                _Pragma("unroll") for (int i = 0; i < 4; ++i) O[2 * (g >> 1) + (i & 1)] = __builtin_amdgcn_mfma_f32_32x32x16_bf16(vf_[i], pf_[2 * (g & 1) + (i >> 1)], O[2 * (g >> 1) + (i & 1)], 0, 0, 0); \
                __builtin_amdgcn_sched_barrier(0); } } while (0)
#define VLD(dst, g) do { _Pragma("unroll") for (int i = 0; i < 4; ++i) dst[i] = *(const LAS bf16x8*)(lds + vcur_ + vfr + (2 * ((g) >> 1) + (i & 1)) * 32 * KPITCH + (2 * ((g) & 1) + (i >> 1)) * 32); } while (0)
#define VMM(src, g) do { _Pragma("unroll") for (int i = 0; i < 4; ++i) O[2 * ((g) >> 1) + (i & 1)] = __builtin_amdgcn_mfma_f32_32x32x16_bf16(src[i], pf_[2 * ((g) & 1) + (i >> 1)], O[2 * ((g) >> 1) + (i & 1)], 0, 0, 0); } while (0)
#define KLD(kd, qd, h2) do { _Pragma("unroll") for (int d2 = 0; d2 < 2; ++d2) { const int dd = 2 * (h2) + d2; qd[d2] = *(const LAS bf16x8*)(lds + qoff + dd * 1024); \
            kd[2 * d2] = *(const LAS bf16x8*)(lds + kcur_ + kfo + dd * 32); kd[2 * d2 + 1] = *(const LAS bf16x8*)(lds + kcur_ + kfo + 32 * KPITCH + dd * 32); } } while (0)
#define KMM(kd, qd) do { _Pragma("unroll") for (int d2 = 0; d2 < 2; ++d2) { s0 = __builtin_amdgcn_mfma_f32_32x32x16_bf16(kd[2 * d2], qd[d2], s0, 0, 0, 0); s1 = __builtin_amdgcn_mfma_f32_32x32x16_bf16(kd[2 * d2 + 1], qd[d2], s1, 0, 0, 0); } } while (0)
#define SB() __builtin_amdgcn_sched_barrier(0)
#define APHASE(vslot, kslot, DOPV, DOQK) do { const int vcur_ = RV + (vslot) * VS_BYTES, kcur_ = (kslot) * KS_BYTES; \
            bf16x8 ga_[4], gb_[4], ka_[4], qa_[2], kb_[4], qb_[2]; \
            if (DOPV) { VLD(ga_, 0); VLD(gb_, 1); SB(); VMM(ga_, 0); SB(); VLD(ga_, 2); SB(); VMM(gb_, 1); SB(); VLD(gb_, 3); SB(); VMM(ga_, 2); SB(); } \
            if (DOQK) { KLD(ka_, qa_, 0); SB(); } \
            if (DOPV) { VMM(gb_, 3); SB(); } \
            if (DOQK) { KLD(kb_, qb_, 1); SB(); \
                _Pragma("unroll") for (int r = 0; r < 16; ++r) { s0[r] = 0.f; s1[r] = 0.f; } \
                KMM(ka_, qa_); SB(); KMM(kb_, qb_); SB(); } } while (0)
#define SOFTMAX(t) do { \
            const float base_ = (float)((t) * 64 + 8 * hi - qpos); \
            float mx_ = -1e30f; \
            { float x0_ = base_, x1_ = base_ + 32.0f; \
              _Pragma("unroll") for (int r = 0; r < 16; ++r) { \
                if (r == 8) { x0_ = base_ + 16.0f; x1_ = base_ + 48.0f; } \
                s0[r] = s0[r] - c2 * fabsf(x0_); s1[r] = s1[r] - c2 * fabsf(x1_); \
                mx_ = fmaxf(mx_, fmaxf(s0[r], s1[r])); x0_ += 1.0f; x1_ += 1.0f; } } \
            mx_ = swap_max(mx_); \
            __builtin_amdgcn_sched_barrier(0); \
            const float mnew_ = fmaxf(mrun, mx_); \
            if (__any(mnew_ > mrun)) { \
                const float alpha_ = __builtin_amdgcn_exp2f(mrun - mnew_); lrun *= alpha_; \
                _Pragma("unroll") for (int db = 0; db < 4; ++db) _Pragma("unroll") for (int r = 0; r < 16; ++r) O[db][r] *= alpha_; \
                mrun = mnew_; } \
            __builtin_amdgcn_sched_barrier(0); \
            float ls_ = 0.f; \
            _Pragma("unroll") for (int r = 0; r < 16; ++r) { s0[r] = __builtin_amdgcn_exp2f(s0[r] - mrun); s1[r] = __builtin_amdgcn_exp2f(s1[r] - mrun); ls_ += s0[r] + s1[r]; } \
            lrun += ls_; \
            __builtin_amdgcn_sched_barrier(0); \
            { u32x4 w_; \
              w_.x = cvt_pk_bf16(s0[0], s0[1]); w_.y = cvt_pk_bf16(s0[2], s0[3]); w_.z = cvt_pk_bf16(s0[4], s0[5]); w_.w = cvt_pk_bf16(s0[6], s0[7]); pf_[0] = __builtin_bit_cast(bf16x8, w_); \
              w_.x = cvt_pk_bf16(s0[8], s0[9]); w_.y = cvt_pk_bf16(s0[10], s0[11]); w_.z = cvt_pk_bf16(s0[12], s0[13]); w_.w = cvt_pk_bf16(s0[14], s0[15]); pf_[1] = __builtin_bit_cast(bf16x8, w_); \
              w_.x = cvt_pk_bf16(s1[0], s1[1]); w_.y = cvt_pk_bf16(s1[2], s1[3]); w_.z = cvt_pk_bf16(s1[4], s1[5]); w_.w = cvt_pk_bf16(s1[6], s1[7]); pf_[2] = __builtin_bit_cast(bf16x8, w_); \
              w_.x = cvt_pk_bf16(s1[8], s1[9]); w_.y = cvt_pk_bf16(s1[10], s1[11]); w_.z = cvt_pk_bf16(s1[12], s1[13]); w_.w = cvt_pk_bf16(s1[14], s1[15]); pf_[3] = __builtin_bit_cast(bf16x8, w_); } \
            __builtin_amdgcn_sched_barrier(0); } while (0)
#define STAGE_WRITE(slot) do { *(LAS u32x4*)(lds + (slot) * KS_BYTES + kdst) = kR; *(LAS u32x4*)(lds + RV + (slot) * VS_BYTES + vdstr0) = vR0; *(LAS u32x4*)(lds + RV + (slot) * VS_BYTES + vdstr1) = vR1; } while (0)
        APHASE(0, 0, false, true); STAGE_WRITE(1); PBAR();
        int sc = 0, sn = 1, sw = 2;
#pragma unroll 1
        for (int t = 0; t < 63; ++t) {
            if (t + 2 < 64) { kR = *(const u32x4*)(ksrc + (size_t)(t + 2) * 64 * 2048); vR0 = *(const u32x4*)(vsrc0 + (t + 2) * 64); vR1 = *(const u32x4*)(vsrc1 + (t + 2) * 64); }
            SOFTMAX(t); PBAR();
            APHASE(sc, sn, true, true);
            if (t + 2 < 64) STAGE_WRITE(sw);
            PBAR();
            { const int t_ = sc; sc = sn; sn = sw; sw = t_; }
        }
        SOFTMAX(63); PBAR();
        APHASE(sc, 0, true, false); PBAR();
        if (!lag) PBAR();
#undef STAGE_WRITE
#undef SOFTMAX
#undef PVM
#undef APHASE
#undef VLD
#undef VMM
#undef KLD
#undef KMM
#undef SB
#undef QKT
#undef PBAR
        const float inv = 1.0f / swap_sum(lrun);
        bf16_t* orow = opm + (rowbase + qpos) * 2048 + h * 128 + 4 * hi;
        if (c == 0) {
#pragma unroll
            for (int db = 0; db < 4; ++db)
#pragma unroll
                for (int g = 0; g < 4; ++g) { u32x2 w; w.x = cvt_pk_bf16(O[db][4 * g] * inv, O[db][4 * g + 1] * inv); w.y = cvt_pk_bf16(O[db][4 * g + 2] * inv, O[db][4 * g + 3] * inv);
                    *(u32x2*)(orow + 32 * db + 8 * g) = w; }
        } else {
            float ss = 0.f;
#pragma unroll
            for (int db = 0; db < 4; ++db) {
#pragma unroll
                for (int g = 0; g < 4; ++g) { const u32x2 w = *(const u32x2*)(orow + 32 * db + 8 * g); const int r = 4 * g;
                    const float a0 = bf_lo(w.x) - lam * (O[db][r] * inv), a1 = bf_hi(w.x) - lam * (O[db][r + 1] * inv), a2 = bf_lo(w.y) - lam * (O[db][r + 2] * inv), a3 = bf_hi(w.y) - lam * (O[db][r + 3] * inv);
                    O[db][r] = a0; O[db][r + 1] = a1; O[db][r + 2] = a2; O[db][r + 3] = a3; ss = fmaf(a0, a0, ss); ss = fmaf(a1, a1, ss); ss = fmaf(a2, a2, ss); ss = fmaf(a3, a3, ss);
                    asm volatile("" : "+v"(ss)); __builtin_amdgcn_sched_barrier(0); } }
            ss = swap_sum(ss);
            const float rn = (1.0f - LAMBDA_INIT) / sqrtf(ss * (1.0f / 128.0f) + SUBLN_EPS);
#pragma unroll
            for (int db = 0; db < 4; ++db)
#pragma unroll
                for (int g = 0; g < 4; ++g) { const int d = 32 * db + 8 * g;
                    const f32x4 gn = *(const f32x4*)(subln_ + d + 4 * hi);
                    u32x2 w; w.x = cvt_pk_bf16(O[db][4 * g] * rn * gn[0], O[db][4 * g + 1] * rn * gn[1]); w.y = cvt_pk_bf16(O[db][4 * g + 2] * rn * gn[2], O[db][4 * g + 3] * rn * gn[3]);
                    *(u32x2*)(orow + d) = w; }
        }
    }
}

#if defined(DBG_STOP)
__device__ __forceinline__ void dbg_dump(const Args& a, int k) {
    const size_t gt = (size_t)blockIdx.x * NTHR + threadIdx.x, NGT = (size_t)gridDim.x * NTHR;
    const bf16_t* b16 = (const bf16_t*)a.ws;
    for (size_t i = gt; i < (size_t)M * DM; i += NGT) {
        const size_t row = i / DM, col = i % DM; float v = 0.f;
        auto B = [&](size_t off, size_t idx) { return __uint_as_float((unsigned)((const bf16_t*)(a.ws + off))[idx] << 16); };
        if (k == 0) { v = B(WS_WIN, i % ((size_t)8192 * 2048)); }
        if (k == 1 && DBG_SEL == 1) { v = B(WS_GATES, row * 4096 + col) + B(WS_GATES, row * 4096 + 2048 + col); }
        if (k == 1 && DBG_SEL == 3) { v = B(WS_QK, i); }
        if (k == 1 && DBG_SEL == 4) { v = B(WS_PZ, row * 1024 + (col & 1023)) + B(WS_VT, row * 1024 + (col & 1023)); }
        if (k == 1 && DBG_SEL == 2) { v = B(WS_WCAT, i % ((size_t)2048 * 2048)); }
        if (k == 1 && DBG_SEL == 0) { v = B(WS_QK, i) + B(WS_PZ, row * 1024 + (col & 1023)) + B(WS_VT, row * 1024 + (col & 1023)) + B(WS_GATES, row * 4096 + col) + B(WS_GATES, row * 4096 + 2048 + col) + B(WS_WCAT, i % ((size_t)2048 * 2048)); }
        if (k == 2) { v = B(WS_OPM, i); }
        if (k == 3) { v = B(WS_MERGED, i) + B(WS_T, i); }
        if (k == 4) { v = ((const float*)(a.ws + WS_MO))[i]; }
        if (k == 5) { v = a.out[i] + B(WS_H2, i); }
        if (k == 6) { v = B(WS_U, row * UPC + col) + B(WS_U, row * UPC + 2048 + col) + B(WS_U, row * UPC + 4096 + col) + B(WS_U, row * UPC + 6144 + col) + B(WS_U, row * UPC + 8192 + col) + B(WS_U, row * UPC + 9216 + col) + B(WS_SIDE, i % ((size_t)1024 * 5632)); }
        if (k == 7) { v = B(WS_U, row * UPC + col) + B(WS_U, row * UPC + 2048 + col) + B(WS_U, row * UPC + 4096 + col) + B(WS_U, row * UPC + 6144 + col) + B(WS_U, row * UPC + 8192 + col) + B(WS_U, row * UPC + 9216 + col); }
        if (k == 8) { v = ((const float*)(a.ws + WS_Y))[i]; }
        a.out[i] = v;
    }
}
#endif

#define XB_TMO      128
#define XB_XCNT(j)  (256  + 64 * (j))
#define XB_XSUB(j)  (1280 + 64 * (j))
#define XB_XGEN(j)  (2304 + 64 * (j))
#define XB_TOP      3328
#define XB_TOPGEN   3392
#define XCD_BAR_WORDS 3456
#define XB_SPIN_CAP (1u << 18)
__device__ __forceinline__ unsigned xb_ld(unsigned* p)              { return __hip_atomic_load(p, __ATOMIC_RELAXED, __HIP_MEMORY_SCOPE_AGENT); }
__device__ __forceinline__ unsigned xb_add(unsigned* p, unsigned v) { return __hip_atomic_fetch_add(p, v, __ATOMIC_RELAXED, __HIP_MEMORY_SCOPE_AGENT); }
__device__ __forceinline__ unsigned xb_xcc_id() { return (unsigned)__builtin_amdgcn_s_getreg((3 << 11) | 20) & 0xFu; }
#define XB_SPIN(cond, bar) do { unsigned _sp = 0; while (cond) { __builtin_amdgcn_s_sleep(1); \
    if ((++_sp & 255u) == 0u) { if (xb_ld(&(bar)[XB_TMO])) break; if (_sp > XB_SPIN_CAP) { atomicAdd(&(bar)[XB_TMO], 1u); break; } } } } while (0)
__device__ __forceinline__ void xcd_barrier_complete(unsigned* bar, unsigned x, unsigned& nloc, unsigned& nx) {
    const unsigned G = gridDim.x * gridDim.y * gridDim.z;
    unsigned sum, cnt, mine, sp = 0u;
    for (;;) {
        sum = 0u; cnt = 0u; mine = 0u;
#pragma unroll
        for (unsigned j = 0; j < 16; ++j) { const unsigned c = xb_ld(&bar[XB_XCNT(j)]); sum += c; cnt += (c > 0u) ? 1u : 0u; mine = (j == x) ? c : mine; }
        if (sum == G) break;
        __builtin_amdgcn_s_sleep(1);
        if ((++sp & 255u) == 0u) { if (xb_ld(&bar[XB_TMO])) break; if (sp > XB_SPIN_CAP) { atomicAdd(&bar[XB_TMO], 1u); break; } }
    }
    nloc = mine > 0u ? mine : 1u; nx = cnt > 0u ? cnt : 1u;
}
__device__ __forceinline__ void xcd_barrier(unsigned* bar, unsigned x, volatile LAS unsigned* st, bool tid0) {
    asm volatile("s_waitcnt vmcnt(0)" ::: "memory");
    __syncthreads();
    if (tid0) {
        __builtin_amdgcn_s_waitcnt(0);
        unsigned nloc = st[0], nx = st[1];
        if (nloc == 0u) { xcd_barrier_complete(bar, x, nloc, nx); st[0] = nloc; st[1] = nx; }
        const unsigned old = xb_add(&bar[XB_XSUB(x)], 1u);
        const unsigned gen = old / nloc;
        if (old + 1u == (gen + 1u) * nloc) {
            __builtin_amdgcn_fence(__ATOMIC_RELEASE, "agent");
            asm volatile("s_waitcnt vmcnt(0)" ::: "memory");
            const unsigned og = xb_add(&bar[XB_TOP], 1u);
            const unsigned tg = og / nx;
            if (og + 1u == (tg + 1u) * nx) xb_add(&bar[XB_TOPGEN], 1u);
            else XB_SPIN(xb_ld(&bar[XB_TOPGEN]) == tg, bar);
            __builtin_amdgcn_fence(__ATOMIC_ACQUIRE, "agent");
            xb_add(&bar[XB_XGEN(x)], 1u);
            asm volatile("s_waitcnt vmcnt(0)" ::: "memory");
        } else {
            XB_SPIN(xb_ld(&bar[XB_XGEN(x)]) == gen, bar);
            __builtin_amdgcn_fence(__ATOMIC_ACQUIRE, "agent");
            asm volatile("s_waitcnt vmcnt(0)" ::: "memory");
        }
    }
    __syncthreads();
}

__device__ unsigned g_bar[64];
__global__ void __launch_bounds__(NTHR, 2) fwd_kernel(Args a) {
    extern __shared__ __attribute__((aligned(16))) unsigned char lds_raw[];
    LAS unsigned char* lds = (LAS unsigned char*)lds_raw;
    cg::grid_group grid = cg::this_grid();
    const int G = gridDim.x, bx = blockIdx.x;
    const int wave0 = __builtin_amdgcn_readfirstlane((int)threadIdx.x >> 6);
    const int vcu = (G % 8 == 0) ? (bx % 8) * (G / 8) + bx / 8 : bx;
    const int NGW = G * NWAVES, NGT = G * NTHR;
    unsigned* const xb_bar = (unsigned*)(a.ws + WS_CTL);
    volatile LAS unsigned* const xb_st = (volatile LAS unsigned*)(lds + LDS_BYTES - 64);
    const unsigned xb_x = xb_xcc_id();
    if (MY_TID(wave0) == 0) { xb_st[0] = 0u; xb_st[1] = 0u; (void)xb_add(&xb_bar[XB_XCNT(xb_x)], 1u); }
    __syncthreads();
    if (a.ws == nullptr) grid.sync();
#define GRID_SYNC() xcd_barrier(xb_bar, xb_x, xb_st, MY_TID(wave0) == 0)
#define PHASE_VIEW() \
    int tid_ = MY_TID(wave0); asm volatile("" : "+v"(tid_)); const int tid = tid_, lane = tid & 63, wave = wave0; \
    const int gw = vcu * NWAVES + wave, gt = bx * NTHR + tid; (void)gw; (void)gt; (void)lane; \
    __attribute__((address_space(1))) unsigned char* ws = (__attribute__((address_space(1))) unsigned char*)a.ws; asm volatile("" : "+s"(ws));     \
    bf16_t* WdownT = (bf16_t*)(ws + WS_WDOWN); bf16_t* WinT = (bf16_t*)(ws + WS_WIN); bf16_t* WoutT = (bf16_t*)(ws + WS_WOUT); \
    bf16_t* WcatT = (bf16_t*)(ws + WS_WCAT); bf16_t* WpT = (bf16_t*)(ws + WS_WPT); bf16_t* PWs = (bf16_t*)(ws + WS_PWS); \
    bf16_t* Hb = (bf16_t*)(ws + WS_H); bf16_t* OPM = (bf16_t*)(ws + WS_OPM); bf16_t* QK = (bf16_t*)(ws + WS_QK); bf16_t* MERGED = (bf16_t*)(ws + WS_MERGED); \
    bf16_t* VT = (bf16_t*)(ws + WS_VT); bf16_t* PZ = (bf16_t*)(ws + WS_PZ); bf16_t* Tb = (bf16_t*)(ws + WS_T); bf16_t* GATES = (bf16_t*)(ws + WS_GATES); \
    float* MO = (float*)(ws + WS_MO); bf16_t* H2 = (bf16_t*)(ws + WS_H2); bf16_t* WupT = (bf16_t*)(ws + WS_WUP); bf16_t* U = (bf16_t*)(ws + WS_U); \
    bf16_t* SIDE = (bf16_t*)(ws + WS_SIDE); float* Y = (float*)(ws + WS_Y); \
    (void)WdownT; (void)WinT; (void)WoutT; (void)WcatT; (void)WpT; (void)PWs; (void)Hb; (void)OPM; (void)QK; (void)MERGED; (void)VT; (void)PZ; (void)Tb; (void)GATES; (void)MO; (void)H2; (void)WupT; (void)U; (void)SIDE; (void)Y;

    if (PH(0)) { PHASE_VIEW()
        LAS float* scr = (LAS float*)(lds + wave * 16384);
        constexpr int I_IN = (DM / 64) * (INC / 32), I_UP = (DM / 64) * (UPC / 32), I_DN = (DFF / 64) * (DM / 32), I_OUT = (DM / 64) * (DM / 32), I_AT = (1024 / 64) * (DM / 32), I_PB = I_AT;
        constexpr int NITEMS = I_IN + I_UP + I_DN + I_OUT + I_AT + I_PB;
        for (int it = gw; it < NITEMS; it += NGW) {
            int r = it;
            if (r < I_IN) { transpose_item<0>(a.w_in, DM, INC, WinT, DM, scr, r, lane); continue; } r -= I_IN;
            if (r < I_UP) { transpose_item<1>(a.w_up, DM, UPC, WupT, DM, scr, r, lane); continue; } r -= I_UP;
            if (r < I_DN) { transpose_item<0>(a.w_down, DFF, DM, WdownT, DFF, scr, r, lane); continue; } r -= I_DN;
            if (r < I_OUT) { transpose_item<0>(a.w_out, DM, DM, WoutT, DM, scr, r, lane); continue; } r -= I_OUT;
            if (r < I_AT) { transpose_item<0>(a.w_attn, 1024, DM, WcatT, DM, scr, r, lane); continue; } r -= I_AT;
            transpose_item<0>(a.w_poolb, 1024, DM, WpT, 1024, scr, r, lane);
        }
        for (int i = gt; i < 1024 * 256 / 4; i += NGT) { const int e = i * 4, gcl = e >> 8, dp = e & 255, g = gcl >> 8;
            const f32x4 w = *(const f32x4*)(a.pool_w + e), sc = *(const f32x4*)(a.pool_scale + g * 256 + dp); const f32x4 o = w * sc;
            u32x2 p; p.x = cvt_pk_bf16(o[0], o[1]); p.y = cvt_pk_bf16(o[2], o[3]); *(u32x2*)(PWs + e) = p; }
        for (int m = gw; m < M; m += NGW) rms_row_bf16(a.x + (size_t)m * DM, a.g_pre_mix, Hb + (size_t)m * DM, lane);
    }
    GRID_SYNC();
#if defined(DBG_STOP)
    if (DBG_STOP == 0) { dbg_dump(a, 0); return; }
#endif

    if (PH(1)) { PHASE_VIEW()
#ifndef NO_MINI
        {
            pg8::Gemm gm{WpT, PWs, 1024, 256, 256, 256, 512};
            pg8::StaticOrder S; S.init(DM, 1024, G, bx);
            pg8::EpiBf16<false> E{WcatT + 1024, DM, nullptr};
            pg8::gemm_phase(lds, gm, S, E, wave0);
        }
#endif
#ifndef NO_Z
        pg8::Gemm gm{Hb, WinT, DM, DM, DM, 256, 0};
        pg8::StaticOrder S; S.init(M, INC, G, bx);
        pg8::EpiZ E{QK, VT, PZ, GATES, a.b_gate, 0.125f * LOG2E};
        pg8::gemm_phase(lds, gm, S, E, wave0);
#endif
    }
    GRID_SYNC();
#if defined(DBG_STOP)
    if (DBG_STOP == 1) { dbg_dump(a, 1); return; }
#endif

    if (PH(2)) { PHASE_VIEW()
        for (int i = gt; i < (M / 16) * 128; i += NGT) {
            const int vec = i & 127, rb = i >> 7, g = vec >> 5, half = 1 << g, row0 = rb * 16, s0 = row0 & (SEQ - 1);
            const bf16_t* base = PZ + (size_t)(row0 - s0) * 1024 + vec * 8;
            bf16_t* outp = OPM + (size_t)row0 * 2048 + 1024 + vec * 8;
            int lo = (s0 - half < 0) ? 0 : s0 - half, hi_ = (s0 + half > SEQ) ? SEQ : s0 + half;
            float acc[8];
#pragma unroll
            for (int j = 0; j < 8; ++j) acc[j] = 0.f;
            for (int r = lo; r < hi_; ++r) { const u32x4 w = *(const u32x4*)(base + (size_t)r * 1024);
                acc[0] += bf_lo(w.x); acc[1] += bf_hi(w.x); acc[2] += bf_lo(w.y); acc[3] += bf_hi(w.y); acc[4] += bf_lo(w.z); acc[5] += bf_hi(w.z); acc[6] += bf_lo(w.w); acc[7] += bf_hi(w.w); }
#pragma unroll 4
            for (int k = 0; k < 16; ++k) {
                const int s = s0 + k;
                const u32x4 w = *(const u32x4*)(base + (size_t)s * 1024);
                const float ic = 1.0f / (float)(hi_ - lo);
                u32x4 o;
                o.x = cvt_pk_bf16(acc[0] * ic - bf_lo(w.x), acc[1] * ic - bf_hi(w.x)); o.y = cvt_pk_bf16(acc[2] * ic - bf_lo(w.y), acc[3] * ic - bf_hi(w.y));
                o.z = cvt_pk_bf16(acc[4] * ic - bf_lo(w.z), acc[5] * ic - bf_hi(w.z)); o.w = cvt_pk_bf16(acc[6] * ic - bf_lo(w.w), acc[7] * ic - bf_hi(w.w));
                *(u32x4*)(outp + (size_t)k * 2048) = o;
                if (s - half >= 0) { const u32x4 q = *(const u32x4*)(base + (size_t)(s - half) * 1024);
                    acc[0] -= bf_lo(q.x); acc[1] -= bf_hi(q.x); acc[2] -= bf_lo(q.y); acc[3] -= bf_hi(q.y); acc[4] -= bf_lo(q.z); acc[5] -= bf_hi(q.z); acc[6] -= bf_lo(q.w); acc[7] -= bf_hi(q.w); ++lo; }
                if (s + half < SEQ) { const u32x4 q = *(const u32x4*)(base + (size_t)(s + half) * 1024);
                    acc[0] += bf_lo(q.x); acc[1] += bf_hi(q.x); acc[2] += bf_lo(q.y); acc[3] += bf_hi(q.y); acc[4] += bf_lo(q.z); acc[5] += bf_hi(q.z); acc[6] += bf_lo(q.w); acc[7] += bf_hi(q.w); ++hi_; }
            }
        }
        const float d1 = wave_sum(a.lq1[lane] * a.lk1[lane]), d2 = wave_sum(a.lq2[lane] * a.lk2[lane]);
        const float lam = expf(d1) - expf(d2) + LAMBDA_INIT;
        for (int uidx = vcu; uidx < NB * NH * 16; uidx += G) {
            const int bh = uidx >> 4, qb = uidx & 15, b = bh >> 3, h = bh & 7;
            const float c2 = exp2f(-(float)(h + 1)) * LOG2E;
            attn_unit(lds, QK, VT, OPM, a.subln, b, h, qb, lam, c2, wave0);
        }
    }
    GRID_SYNC();
#if defined(DBG_STOP)
    if (DBG_STOP == 2) { dbg_dump(a, 2); return; }
#endif

    if (PH(3)) { PHASE_VIEW()
        pg8::StaticOrder S; S.init(M, DM, G, bx);
        { pg8::Gemm gm{OPM, WcatT, DM, DM, DM, 256, 0}; pg8::EpiGateMid E{GATES, MERGED}; pg8::gemm_phase(lds, gm, S, E, wave0); }
    }
    GRID_SYNC();
#if defined(DBG_STOP)
    if (DBG_STOP == 3) { dbg_dump(a, 3); return; }
#endif

    if (PH(4)) { PHASE_VIEW()
        pg8::Gemm gm{MERGED, WoutT, DM, DM, DM, 256, 0}; pg8::StaticOrder S; S.init(M, DM, G, bx);
        pg8::EpiF32 E{MO, DM}; pg8::gemm_phase(lds, gm, S, E, wave0);
    }
    GRID_SYNC();
#if defined(DBG_STOP)
    if (DBG_STOP == 4) { dbg_dump(a, 4); return; }
#endif

    if (PH(5)) { PHASE_VIEW()
    for (int m = gw; m < M; m += NGW) {
        const float* mor = MO + (size_t)m * DM; const float* xr = a.x + (size_t)m * DM; float* o = a.out + (size_t)m * DM; bf16_t* h2r = H2 + (size_t)m * DM;
        f32x4 v[8]; float s = 0.f;
#pragma unroll
        for (int j = 0; j < 8; ++j) { v[j] = __builtin_nontemporal_load((const f32x4*)(mor + 256 * j + 4 * lane)); s += (v[j][0] * v[j][0] + v[j][1] * v[j][1]) + (v[j][2] * v[j][2] + v[j][3] * v[j][3]); }
        const float rs = 1.0f / sqrtf(wave_sum(s) * (1.0f / DM) + NORM_EPS);
        float s2 = 0.f;
#pragma unroll
        for (int j = 0; j < 8; ++j) { const f32x4 gg = *(const f32x4*)(a.g_post_mix + 256 * j + 4 * lane), xx = __builtin_nontemporal_load((const f32x4*)(xr + 256 * j + 4 * lane));
            v[j] = xx + v[j] * rs * gg; *(f32x4*)(o + 256 * j + 4 * lane) = v[j];
            s2 += (v[j][0] * v[j][0] + v[j][1] * v[j][1]) + (v[j][2] * v[j][2] + v[j][3] * v[j][3]); }
        const float rs2 = 1.0f / sqrtf(wave_sum(s2) * (1.0f / DM) + NORM_EPS);
#pragma unroll
        for (int j = 0; j < 8; ++j) { const f32x4 gg = *(const f32x4*)(a.g_pre_ffn + 256 * j + 4 * lane); const f32x4 q = v[j] * rs2 * gg;
            u32x2 w; w.x = cvt_pk_bf16(q[0], q[1]); w.y = cvt_pk_bf16(q[2], q[3]); *(u32x2*)(h2r + 256 * j + 4 * lane) = w; }
    } }
    GRID_SYNC();
#if defined(DBG_STOP)
    if (DBG_STOP == 5) { dbg_dump(a, 5); return; }
#endif

    if (PH(6)) { PHASE_VIEW()
        pg8::Gemm gm{H2, WupT, DM, DM, DM, 256, 0}; pg8::StaticOrder S; S.init(M, UPC, G, bx);
        pg8::EpiConv E{U, SIDE, a.conv_w, a.conv_b, lds + pg8::STAGE_BYTES}; pg8::gemm_phase(lds, gm, S, E, wave0);
    }
    GRID_SYNC();
#if defined(DBG_STOP)
    if (DBG_STOP == 6) { dbg_dump(a, 6); return; }
#endif

    if (PH(7)) { PHASE_VIEW()
    for (int it = gt; it < 256 * 2 * 704; it += NGT) {
        const int v8 = it % 704, which = (it / 704) & 1, k = it / 1408, ch = 8 * v8;
        const int r = which ? 64 * k + 63 : 64 * k;
        const bool seq_first = (r & (SEQ - 1)) == 0, seq_last = ((r + 1) & (SEQ - 1)) == 0;
        const bf16_t* sk = SIDE + (size_t)k * 4 * UPC + ch;
        const bf16_t* pp = which ? sk + 2 * UPC : (seq_first ? sk : sk - UPC);
        const bf16_t* pc = which ? sk + 3 * UPC : sk;
        const bf16_t* pn = which ? (seq_last ? sk : sk + 4 * UPC) : sk + UPC;
        const bool zp = (!which) && seq_first, zn = which && seq_last;
        const u32x4 z4 = {0u, 0u, 0u, 0u};
        u32x4 gp = *(const u32x4*)pp, gc = *(const u32x4*)pc, gn = *(const u32x4*)pn, vp = *(const u32x4*)(pp + DFF), vc = *(const u32x4*)(pc + DFF), vn = *(const u32x4*)(pn + DFF);
        if (zp) { gp = z4; vp = z4; } if (zn) { gn = z4; vn = z4; }
        const unsigned gpw[4] = {gp.x, gp.y, gp.z, gp.w}, gcw[4] = {gc.x, gc.y, gc.z, gc.w}, gnw[4] = {gn.x, gn.y, gn.z, gn.w};
        const unsigned vpw[4] = {vp.x, vp.y, vp.z, vp.w}, vcw[4] = {vc.x, vc.y, vc.z, vc.w}, vnw[4] = {vn.x, vn.y, vn.z, vn.w};
        float tg[3][8], tv[3][8], tb[2][8];
#pragma unroll
        for (int k3 = 0; k3 < 3; ++k3)
#pragma unroll
            for (int hq = 0; hq < 2; ++hq) { const f32x4 x = *(const f32x4*)(a.conv_w + (size_t)k3 * UPC + ch + 4 * hq), y = *(const f32x4*)(a.conv_w + (size_t)k3 * UPC + DFF + ch + 4 * hq);
#pragma unroll
                for (int e = 0; e < 4; ++e) { tg[k3][4 * hq + e] = x[e]; tv[k3][4 * hq + e] = y[e]; } }
#pragma unroll
        for (int hq = 0; hq < 2; ++hq) { const f32x4 x = *(const f32x4*)(a.conv_b + ch + 4 * hq), y = *(const f32x4*)(a.conv_b + DFF + ch + 4 * hq);
#pragma unroll
            for (int e = 0; e < 4; ++e) { tb[0][4 * hq + e] = x[e]; tb[1][4 * hq + e] = y[e]; } }
        unsigned ow[4];
#pragma unroll
        for (int q = 0; q < 4; ++q) {
            const int e0 = 2 * q, e1 = e0 + 1;
            const float g0 = tg[0][e0] * bf_lo(gpw[q]) + tg[1][e0] * bf_lo(gcw[q]) + tg[2][e0] * bf_lo(gnw[q]) + tb[0][e0];
            const float g1 = tg[0][e1] * bf_hi(gpw[q]) + tg[1][e1] * bf_hi(gcw[q]) + tg[2][e1] * bf_hi(gnw[q]) + tb[0][e1];
            const float x0 = tv[0][e0] * bf_lo(vpw[q]) + tv[1][e0] * bf_lo(vcw[q]) + tv[2][e0] * bf_lo(vnw[q]) + tb[1][e0];
            const float x1 = tv[0][e1] * bf_hi(vpw[q]) + tv[1][e1] * bf_hi(vcw[q]) + tv[2][e1] * bf_hi(vnw[q]) + tb[1][e1];
            ow[q] = cvt_pk_bf16(gelu_tanh(g0) * x0, gelu_tanh(g1) * x1);
        }
        u32x4 o; o.x = ow[0]; o.y = ow[1]; o.z = ow[2]; o.w = ow[3];
        *(u32x4*)(U + (size_t)r * DFF + ch) = o;
    } }
    GRID_SYNC();
#if defined(DBG_STOP)
    if (DBG_STOP == 7) { dbg_dump(a, 7); return; }
#endif

    if (PH(8)) { PHASE_VIEW()
        pg8::Gemm gm{U, WdownT, DFF, DFF, DFF, 256, 0}; pg8::StaticOrder S; S.init(M, DM, G, bx);
        pg8::EpiF32 E{Y, DM}; pg8::gemm_phase(lds, gm, S, E, wave0);
    }
    GRID_SYNC();
#if defined(DBG_STOP)
    if (DBG_STOP == 8) { dbg_dump(a, 8); return; }
#endif

    if (PH(9)) { PHASE_VIEW()
    for (int m = gw; m < M; m += NGW) {
        const float* yr = Y + (size_t)m * DM; float* o = a.out + (size_t)m * DM;
        f32x4 v[8]; float s = 0.f;
#pragma unroll
        for (int j = 0; j < 8; ++j) { v[j] = __builtin_nontemporal_load((const f32x4*)(yr + 256 * j + 4 * lane)); s += (v[j][0] * v[j][0] + v[j][1] * v[j][1]) + (v[j][2] * v[j][2] + v[j][3] * v[j][3]); }
        const float rs = 1.0f / sqrtf(wave_sum(s) * (1.0f / DM) + NORM_EPS);
#pragma unroll
        for (int j = 0; j < 8; ++j) { const f32x4 gg = *(const f32x4*)(a.g_post_ffn + 256 * j + 4 * lane), xx = *(const f32x4*)(o + 256 * j + 4 * lane);
            *(f32x4*)(o + 256 * j + 4 * lane) = xx + v[j] * rs * gg; }
    } }
}

extern "C" void kernel_launch(void* const* d_in, const int* in_sizes, int n_in, void* d_out, int out_size, void* d_ws, size_t ws_size, hipStream_t stream) {
    static int grid = 0;
    if (grid == 0) {
        if (n_in != 21 || in_sizes[0] != M * DM || out_size != M * DM || ws_size < WS_NEED) { fprintf(stderr, "kernel_launch: unexpected shapes / workspace (n_in %d, ws %zu)\n", n_in, ws_size); grid = -1; return; }
        int dev = 0, cus = 0, per_cu = 0;
        (void)hipGetDevice(&dev);
        (void)hipDeviceGetAttribute(&cus, hipDeviceAttributeMultiprocessorCount, dev);
        if (hipFuncSetAttribute((const void*)fwd_kernel, hipFuncAttributeMaxDynamicSharedMemorySize, LDS_BYTES) != hipSuccess) { fprintf(stderr, "kernel_launch: hipFuncSetAttribute failed\n"); grid = -1; return; }
        (void)hipOccupancyMaxActiveBlocksPerMultiprocessor(&per_cu, (const void*)fwd_kernel, NTHR, LDS_BYTES);
        (void)hipGetLastError();
        if (per_cu < 1) per_cu = 1;
        grid = cus;
    }
    if (grid < 0) return;
    Args a{};
    a.x = (const float*)d_in[0]; a.g_pre_mix = (const float*)d_in[1]; a.w_in = (const float*)d_in[2]; a.b_gate = (const float*)d_in[3];
    a.lq1 = (const float*)d_in[4]; a.lk1 = (const float*)d_in[5]; a.lq2 = (const float*)d_in[6]; a.lk2 = (const float*)d_in[7]; a.subln = (const float*)d_in[8];
    a.w_attn = (const float*)d_in[9]; a.pool_w = (const float*)d_in[10]; a.pool_scale = (const float*)d_in[11]; a.w_poolb = (const float*)d_in[12]; a.w_out = (const float*)d_in[13];
    a.g_post_mix = (const float*)d_in[14]; a.g_pre_ffn = (const float*)d_in[15]; a.w_up = (const float*)d_in[16]; a.conv_w = (const float*)d_in[17]; a.conv_b = (const float*)d_in[18];
    a.w_down = (const float*)d_in[19]; a.g_post_ffn = (const float*)d_in[20];
    a.out = (float*)d_out; a.ws = (unsigned char*)d_ws;
    if (hipMemsetAsync((char*)d_ws + WS_CTL, 0, 16384, stream) != hipSuccess) { fprintf(stderr, "kernel_launch: memset of the barrier words failed\n"); return; }
    void* args[] = {&a};
    hipError_t e = hipLaunchCooperativeKernel((const void*)fwd_kernel, dim3(grid), dim3(NTHR), args, LDS_BYTES, stream);
    if (e != hipSuccess) fprintf(stderr, "cooperative launch failed: %s (grid %d)\n", hipGetErrorString(e), grid);
}
```
